# Optimizing an MI355X kernel written in HIP

```python
import jax, jax.numpy as jnp
from jax import lax
import numpy as np

D_MODEL = 1024
BATCH = 4
SEQ = 8192
DEPTH = 1

CTX_LEN = 256
GRID_W = 64
M_HEADS = 4
M_DK = 128
M_DV = 128
M_QK = M_HEADS * M_DK
M_WIDTH = M_HEADS * M_DV
M_CHUNK = 128
CONV_K = 3
G_HEADS = 4
G_DK = 64
G_DV = 128
G_QK = G_HEADS * G_DK
G_WIDTH = G_HEADS * G_DV
G_RANK = 16
G_TAU = 16.0
G_CHUNK = 64
MIX_WIDTH = M_WIDTH + G_WIDTH
IN_COLS = 2 * M_QK + 2 * M_WIDTH + 4 * M_HEADS + 2 * G_QK + 2 * G_WIDTH + 2 * G_RANK
D_FF = ((8 * D_MODEL // 3 + 255) // 256) * 256
EPS = 1e-6
NEG = -1e30

kernel_name = "hymba_mlstm_gla_prefix_block"


def rmsnorm(x, g):
    xf = x.astype(jnp.float32)
    y = xf * lax.rsqrt(jnp.mean(xf * xf, -1, keepdims=True) + EPS)
    return (y * g.astype(jnp.float32)).astype(x.dtype)


def head_rmsnorm(h, g):
    b, nh, t, d = h.shape
    y = h * lax.rsqrt(jnp.mean(h * h, -1, keepdims=True) + EPS)
    y = jnp.transpose(y, (0, 2, 1, 3)).reshape(b, t, nh * d)
    return y * g.astype(jnp.float32)


def modulate(h, shift, scale):
    return h * (1 + scale) + shift


def heads(a, nh):
    b, t, w = a.shape
    return a.reshape(b, t, nh, w // nh).transpose(0, 2, 1, 3).astype(jnp.float32)


def flip(a):
    return jnp.flip(a, 2)


def dwconv2d(u, w, rows, cols):
    b, n, ch = u.shape
    img = u.reshape(b, rows, cols, ch)
    out = lax.conv_general_dilated(img, w[:, :, None, :].astype(u.dtype), window_strides=(1, 1), padding='SAME',
                                   dimension_numbers=('NHWC', 'HWIO', 'NHWC'), feature_group_count=ch)
    return out.reshape(b, n, ch)


def to_chunks(a, chunk):
    b, h, t = a.shape[:3]
    a = a.reshape(b, h, t // chunk, chunk, *a.shape[3:])
    return jnp.moveaxis(a, 2, 0)


def from_chunks(a):
    a = jnp.moveaxis(a, 0, 2)
    return a.reshape(a.shape[0], a.shape[1], -1, a.shape[-1])


def mlstm_scan(q, k, v, logi, logf, state):
    xs = tuple(to_chunks(a, M_CHUNK) for a in (q, k, v, logi, logf))
    lower = jnp.tril(jnp.ones((M_CHUNK, M_CHUNK), bool))

    def step(carry, inp):
        C, nv, m = carry
        qc, kc, vc, ic, fc = inp
        bcum = jnp.cumsum(fc, -1)
        dmat = jnp.where(lower, bcum[..., :, None] - bcum[..., None, :] + ic[..., None, :], NEG)
        inter = m[..., None] + bcum
        m_t = jnp.maximum(inter, jnp.max(dmat, -1))
        w_inter = jnp.exp(inter - m_t)
        scores = jnp.einsum('bhtd,bhsd->bhts', qc, kc) * jnp.exp(dmat - m_t[..., None])
        num = w_inter[..., None] * jnp.einsum('bhtd,bhde->bhte', qc, C) + jnp.einsum('bhts,bhse->bhte', scores, vc)
        den = w_inter * jnp.einsum('bhtd,bhd->bht', qc, nv) + jnp.sum(scores, -1)
        hout = num / jnp.maximum(jnp.abs(den), jnp.exp(-m_t))[..., None]
        btot = bcum[..., -1]
        src = btot[..., None] - bcum + ic
        m_new = jnp.maximum(m + btot, jnp.max(src, -1))
        ws = jnp.exp(src - m_new[..., None])
        wc = jnp.exp(m + btot - m_new)
        C_new = wc[..., None, None] * C + jnp.einsum('bhs,bhsd,bhse->bhde', ws, kc, vc)
        n_new = wc[..., None] * nv + jnp.einsum('bhs,bhsd->bhd', ws, kc)
        return (C_new, n_new, m_new), hout

    state, hs = lax.scan(step, state, xs)
    return from_chunks(hs), state


def mlstm_state(k, v, logi, logf):
    bcum = jnp.cumsum(logf, -1)
    src = bcum[..., -1:] - bcum + logi
    m = jnp.max(src, -1)
    w = jnp.exp(src - m[..., None])
    return (jnp.einsum('bhs,bhsd,bhse->bhde', w, k, v), jnp.einsum('bhs,bhsd->bhd', w, k), m)


def gla_scan(q, k, v, loga, S):
    xs = tuple(to_chunks(a, G_CHUNK) for a in (q, k, v, loga))
    lower = jnp.tril(jnp.ones((G_CHUNK, G_CHUNK), bool))[..., None]

    def step(S, inp):
        qc, kc, vc, ac = inp
        bcum = jnp.cumsum(ac, -2)
        decay = jnp.where(lower, bcum[..., :, None, :] - bcum[..., None, :, :], NEG)
        att = jnp.einsum('bhtk,bhsk,bhtsk->bhts', qc, kc, jnp.exp(decay))
        out = jnp.einsum('bhtk,bhkv->bhtv', qc * jnp.exp(bcum), S) + jnp.einsum('bhts,bhsv->bhtv', att, vc)
        btot = bcum[..., -1:, :]
        S_new = jnp.exp(btot[..., 0, :])[..., None] * S + jnp.einsum('bhsk,bhsv->bhkv', kc * jnp.exp(btot - bcum), vc)
        return S_new, out

    S, outs = lax.scan(step, S, xs)
    return from_chunks(outs), S


def gla_state(k, v, loga):
    bcum = jnp.cumsum(loga, -2)
    return jnp.einsum('bhsk,bhsv->bhkv', k * jnp.exp(bcum[..., -1:, :] - bcum), v)


def mixer_features(h, w_in, conv_w, m_gate_b, g_gate_w, g_gate_b, rows, cols):
    z = h @ w_in
    sizes = (2 * M_QK, M_WIDTH, M_WIDTH, 4 * M_HEADS, G_QK, G_QK, G_WIDTH, G_WIDTH, 2 * G_RANK)
    parts, off = [], 0
    for s in sizes:
        parts.append(z[..., off:off + s])
        off += s
    mqk, mv, mo, mg, gq, gk, gv, gr, glr = parts
    mqk = jax.nn.silu(dwconv2d(mqk, conv_w, rows, cols))
    mq, mk = jnp.split(mqk, 2, -1)
    b, t, _ = h.shape
    mg = (mg + m_gate_b).astype(jnp.float32).reshape(b, t, 4, M_HEADS).transpose(2, 0, 3, 1)
    loga = [jax.nn.log_sigmoid((glr[..., i * G_RANK:(i + 1) * G_RANK] @ g_gate_w[i] + g_gate_b[i]).astype(jnp.float32)) / G_TAU
            for i in range(2)]
    return dict(
        mq=heads(mq, M_HEADS), mk=heads(mk, M_HEADS) * (M_DK ** -0.5), mv=heads(mv, M_HEADS), mo=mo,
        mi_f=mg[0], mf_f=jax.nn.log_sigmoid(mg[1]), mi_b=mg[2], mf_b=jax.nn.log_sigmoid(mg[3]),
        gq=heads(gq, G_HEADS) * (G_DK ** -0.5), gk=heads(gk, G_HEADS), gv=heads(gv, G_HEADS), gr=gr,
        ga_f=heads(loga[0], G_HEADS), ga_b=heads(loga[1], G_HEADS))


def zero_states(b):
    f32 = jnp.float32
    ms = (jnp.zeros((b, M_HEADS, M_DK, M_DV), f32), jnp.zeros((b, M_HEADS, M_DK), f32), jnp.full((b, M_HEADS), NEG, f32))
    gs = jnp.zeros((b, G_HEADS, G_DK, G_DV), f32)
    return (ms, ms, gs, gs)


def context_states(f):
    return (mlstm_state(f['mk'], f['mv'], f['mi_f'], f['mf_f']),
            mlstm_state(flip(f['mk']), flip(f['mv']), flip(f['mi_b']), flip(f['mf_b'])),
            gla_state(f['gk'], f['gv'], f['ga_f']),
            gla_state(flip(f['gk']), flip(f['gv']), flip(f['ga_b'])))


def mixer_apply(f, states, m_norm_g, g_norm_g, w_out):
    smf, smb, sgf, sgb = states
    hf, smf = mlstm_scan(f['mq'], f['mk'], f['mv'], f['mi_f'], f['mf_f'], smf)
    hb, smb = mlstm_scan(flip(f['mq']), flip(f['mk']), flip(f['mv']), flip(f['mi_b']), flip(f['mf_b']), smb)
    hm = head_rmsnorm(hf + flip(hb), m_norm_g) * jax.nn.sigmoid(f['mo'].astype(jnp.float32))
    of, sgf = gla_scan(f['gq'], f['gk'], f['gv'], f['ga_f'], sgf)
    ob, sgb = gla_scan(flip(f['gq']), flip(f['gk']), flip(f['gv']), flip(f['ga_b']), sgb)
    hg = head_rmsnorm(of + flip(ob), g_norm_g) * jax.nn.silu(f['gr'].astype(jnp.float32))
    out = jnp.concatenate([hm, hg], -1).astype(w_out.dtype) @ w_out
    return out, (smf, smb, sgf, sgb)


def swiglu(h, w_gu, w_down):
    a, g = jnp.split(h @ w_gu, 2, -1)
    return (jax.nn.silu(a) * g) @ w_down


def setup_inputs(seed: int = 0) -> dict:
    key = jax.random.key(seed)
    ks = jax.random.split(key, 24)
    f32 = jnp.float32
    D = D_MODEL

    def nrm(k, shape, s):
        return s * jax.random.normal(k, shape, f32)

    fb = jnp.linspace(3.0, 6.0, M_HEADS, dtype=f32)
    zb = jnp.zeros((M_HEADS,), f32)
    m_gate_base = jnp.concatenate([zb, fb, zb, fb])
    return {
        "x": nrm(ks[0], (BATCH, SEQ, D), 1.0),
        "c": nrm(ks[1], (BATCH, D), 1.0),
        "ctx": nrm(ks[2], (BATCH, CTX_LEN, D), 1.0),
        "c_ctx": nrm(ks[3], (D,), 1.0),
        "w_ada": nrm(ks[4], (DEPTH, D, 6 * D), 0.5 * D ** -0.5),
        "b_ada": nrm(ks[5], (DEPTH, 6 * D), 0.01),
        "g_mix": 1.0 + nrm(ks[6], (DEPTH, D), 0.02),
        "w_in": nrm(ks[7], (DEPTH, D, IN_COLS), D ** -0.5),
        "conv_w": nrm(ks[8], (DEPTH, CONV_K, CONV_K, 2 * M_QK), 1.0 / CONV_K),
        "m_gate_b": m_gate_base + nrm(ks[9], (DEPTH, 4 * M_HEADS), 0.1),
        "m_norm_g": 1.0 + nrm(ks[10], (DEPTH, M_WIDTH), 0.02),
        "g_gate_w": nrm(ks[11], (DEPTH, 2, G_RANK, G_QK), G_RANK ** -0.5),
        "g_gate_b": nrm(ks[12], (DEPTH, 2, G_QK), 0.01),
        "g_norm_g": 1.0 + nrm(ks[13], (DEPTH, G_WIDTH), 0.02),
        "w_out": nrm(ks[14], (DEPTH, MIX_WIDTH, D), MIX_WIDTH ** -0.5),
        "g_ffn": 1.0 + nrm(ks[15], (DEPTH, D), 0.02),
        "w_gu": nrm(ks[16], (DEPTH, D, 2 * D_FF), D ** -0.5),
        "w_down": nrm(ks[17], (DEPTH, D_FF, D), D_FF ** -0.5),
        "g_final": 1.0 + nrm(ks[18], (D,), 0.02),
    }


def reference(x, c, ctx, c_ctx, w_ada, b_ada, g_mix, w_in, conv_w, m_gate_b, m_norm_g, g_gate_w, g_gate_b,
              g_norm_g, w_out, g_ffn, w_gu, w_down, g_final):
    rows = x.shape[1] // GRID_W
    h_ctx = ctx
    for l in range(DEPTH):
        last = l == DEPTH - 1
        mod_x = (jax.nn.silu(c) @ w_ada[l] + b_ada[l])[:, None, :]
        mod_c = jax.nn.silu(c_ctx) @ w_ada[l] + b_ada[l]
        shx1, scx1, gx1, shx2, scx2, gx2 = jnp.split(mod_x, 6, -1)
        shc1, scc1, gc1, shc2, scc2, gc2 = jnp.split(mod_c, 6, -1)
        proj = (w_in[l], conv_w[l], m_gate_b[l], g_gate_w[l], g_gate_b[l])
        fc = mixer_features(modulate(rmsnorm(h_ctx, g_mix[l]), shc1, scc1), *proj, 1, h_ctx.shape[1])
        fx = mixer_features(modulate(rmsnorm(x, g_mix[l]), shx1, scx1), *proj, rows, GRID_W)
        if last:
            ctx_st = context_states(fc)
        else:
            oc, ctx_st = mixer_apply(fc, zero_states(h_ctx.shape[0]), m_norm_g[l], g_norm_g[l], w_out[l])
            h_ctx = h_ctx + gc1 * oc
            h_ctx = h_ctx + gc2 * swiglu(modulate(rmsnorm(h_ctx, g_ffn[l]), shc2, scc2), w_gu[l], w_down[l])
        ox, _ = mixer_apply(fx, ctx_st, m_norm_g[l], g_norm_g[l], w_out[l])
        x = x + gx1 * ox
        x = x + gx2 * swiglu(modulate(rmsnorm(x, g_ffn[l]), shx2, scx2), w_gu[l], w_down[l])
    return rmsnorm(x, g_final)
```

```cpp
#include <hip/hip_runtime.h>
#include <hip/hip_cooperative_groups.h>
#include <cstdio>
#include <cstdint>
namespace cg = cooperative_groups;
namespace pg8 {
#define PG8_LAS __attribute__((address_space(3)))
typedef unsigned short bf16_t;
typedef short bf16x8 __attribute__((ext_vector_type(8)));
typedef float f32x4 __attribute__((ext_vector_type(4)));
typedef unsigned u32x4 __attribute__((ext_vector_type(4)));
constexpr int BM = 256, BK = 64, HALF = 128, HTB = HALF * BK * 2  , STAGE_BYTES = 8 * HTB, NXCD = 8, WGM = 8;

__host__ __device__ __forceinline__ int lds_byte(int r, int c) { const int st = (r >> 4) * 2 + (c >> 5), rr = r & 15, cc = c & 31, ob = rr * 64 + cc * 2; return st * 1024 + (ob ^ (((ob >> 9) & 1) << 5)); }
__host__ __device__ __forceinline__ void stage_rc(int b, int& R, int& C) { const int st = b / 1024, sb = b % 1024, swz = sb ^ (((sb >> 9) & 1) << 5); R = (st >> 1) * 16 + swz / 64; C = (st & 1) * 32 + (swz % 64) / 2; }
__host__ __device__ __forceinline__ int perm32(int rho) { const int n = rho >> 4, i = rho & 15; return 8 * (i >> 2) + 4 * n + (i & 3); }

struct Unit { int pm, pn; };
struct Gemm { const bf16_t* A; const bf16_t* Bt; int M, N, K; };

struct StaticOrder {
    int nM, nN, nwg, G, c, wgm;
    __host__ __device__ void init(int M, int N, int G_, int c_, int wgm_ = WGM) { nM = M / BM; nN = N / BM; nwg = nM * nN; G = G_; c = c_; wgm = wgm_; }
    __host__ __device__ bool next(int i, Unit& u) const {
        const long L = (long)i * G + c; if (L >= nwg) return false;
        int wgid = (int)L; { const int q = nwg / NXCD, r = nwg % NXCD, xcd = wgid % NXCD, off = wgid / NXCD; wgid = (xcd < r ? xcd * (q + 1) : r * (q + 1) + (xcd - r) * q) + off; }
        const int nig = wgm * nN, gid = wgid / nig, fm = gid * wgm, gsz = (nM - fm) < wgm ? (nM - fm) : wgm;
        u.pm = fm + ((wgid % nig) % gsz); u.pn = (wgid % nig) / gsz; return true;
    }
    __device__ __forceinline__ void a_ready(const Unit&) const {}
    __device__ __forceinline__ void done(const Unit&) const {}
};

__device__ __forceinline__ unsigned cvt_pk_bf16(float lo, float hi) { unsigned r; asm volatile("v_cvt_pk_bf16_f32 %0, %1, %2" : "=v"(r) : "v"(lo), "v"(hi)); return r; }
typedef float f32x2 __attribute__((ext_vector_type(2)));
typedef float f32x4e __attribute__((ext_vector_type(4)));
__device__ __forceinline__ float silu_f(float a) { return a * __builtin_amdgcn_rcpf(1.0f + __expf(-a)); }
struct EpiZ {
    static constexpr bool PERM = true, AFTER_DRAIN = false;
    bf16_t* zqk; bf16_t* zr; float* gates;
    __device__ __forceinline__ void operator()(const f32x4 (&acc)[2][2][4][2], const Unit& u, int wr, int wc, int fr, int fq) const {
        const int row0 = u.pm * BM + wr * 64 + fr;
        if (u.pn < 14) {
            bf16_t* base; int ldc, colt;
            if (u.pn < 4) { base = zqk; ldc = 1024; colt = u.pn * 256; } else { base = zr; ldc = 2560; colt = (u.pn - 4) * 256; }
            const int col0 = colt + wc * 32 + 8 * fq;
#pragma unroll
            for (int ai = 0; ai < 2; ++ai)
#pragma unroll
                for (int m = 0; m < 4; ++m) { bf16_t* rowp = base + (size_t)(row0 + ai * HALF + m * 16) * ldc + col0;
#pragma unroll
                    for (int bj = 0; bj < 2; ++bj) { const f32x4 v0 = acc[ai][bj][m][0], v1 = acc[ai][bj][m][1];
                        u32x4 w; w.x = cvt_pk_bf16(v0[0], v0[1]); w.y = cvt_pk_bf16(v0[2], v0[3]); w.z = cvt_pk_bf16(v1[0], v1[1]); w.w = cvt_pk_bf16(v1[2], v1[3]);
                        __builtin_nontemporal_store(w, (u32x4*)(rowp + bj * HALF)); } }
        } else if (wc < 2) {
#pragma unroll
            for (int ai = 0; ai < 2; ++ai)
#pragma unroll
                for (int m = 0; m < 4; ++m) { float* rowp = gates + (size_t)(row0 + ai * HALF + m * 16) * 64 + wc * 32 + 8 * fq;
                    *(f32x4*)(rowp) = acc[ai][0][m][0]; *(f32x4*)(rowp + 4) = acc[ai][0][m][1]; }
        }
    }
};
struct EpiRes {
    static constexpr bool PERM = false, AFTER_DRAIN = false;
    const float* base; float* out; const float* mod; int goff;
    __device__ __forceinline__ void operator()(const f32x4 (&acc)[2][2][4][2], const Unit& u, int wr, int wc, int fr, int fq) const {
        const int row0 = u.pm * BM + wr * 64 + fr, b = u.pm >> 5;
        const int col0 = u.pn * BM + wc * 32 + 4 * fq;
        f32x4 gv[2][2];
#pragma unroll
        for (int bj = 0; bj < 2; ++bj)
#pragma unroll
            for (int n = 0; n < 2; ++n) gv[bj][n] = *(const f32x4*)(mod + b * 6144 + goff + col0 + bj * HALF + n * 16);
#pragma unroll
        for (int ai = 0; ai < 2; ++ai)
#pragma unroll
            for (int m = 0; m < 4; ++m) { const size_t off = (size_t)(row0 + ai * HALF + m * 16) * 1024 + col0;
#pragma unroll
                for (int bj = 0; bj < 2; ++bj)
#pragma unroll
                    for (int n = 0; n < 2; ++n) { const f32x4 bs = *(const f32x4*)(base + off + bj * HALF + n * 16);
                        *(f32x4*)(out + off + bj * HALF + n * 16) = bs + gv[bj][n] * acc[ai][bj][m][n]; } }
    }
};
struct EpiGU {
    static constexpr bool PERM = true, AFTER_DRAIN = false;
    bf16_t* act;
    __device__ __forceinline__ void operator()(const f32x4 (&acc)[2][2][4][2], const Unit& u, int wr, int wc, int fr, int fq) const {
        const int row0 = u.pm * BM + wr * 64 + fr, col0 = u.pn * HALF + wc * 32 + 8 * fq;
#pragma unroll
        for (int ai = 0; ai < 2; ++ai)
#pragma unroll
            for (int m = 0; m < 4; ++m) { bf16_t* rowp = act + (size_t)(row0 + ai * HALF + m * 16) * 2816 + col0;
                const f32x4 a0 = acc[ai][0][m][0], a1 = acc[ai][0][m][1], g0 = acc[ai][1][m][0], g1 = acc[ai][1][m][1];
                u32x4 w; w.x = cvt_pk_bf16(silu_f(a0[0]) * g0[0], silu_f(a0[1]) * g0[1]); w.y = cvt_pk_bf16(silu_f(a0[2]) * g0[2], silu_f(a0[3]) * g0[3]);
                w.z = cvt_pk_bf16(silu_f(a1[0]) * g1[0], silu_f(a1[1]) * g1[1]); w.w = cvt_pk_bf16(silu_f(a1[2]) * g1[2], silu_f(a1[3]) * g1[3]);
                __builtin_nontemporal_store(w, (u32x4*)(rowp)); }
    }
};
template <bool BASEB> struct EpiResB {
    static constexpr bool PERM = true, AFTER_DRAIN = false;
    const void* base; bf16_t* out; const float* mod; int goff;
    __device__ __forceinline__ void operator()(const f32x4 (&acc)[2][2][4][2], const Unit& u, int wr, int wc, int fr, int fq) const {
        const int row0 = u.pm * BM + wr * 64 + fr, b = u.pm >> 5;
        const int col0 = u.pn * BM + wc * 32 + 8 * fq;
        f32x4 gv[2][2];
#pragma unroll
        for (int bj = 0; bj < 2; ++bj)
#pragma unroll
            for (int n = 0; n < 2; ++n) gv[bj][n] = *(const f32x4*)(mod + b * 6144 + goff + col0 + bj * HALF + 4 * n);
#pragma unroll
        for (int ai = 0; ai < 2; ++ai)
#pragma unroll
            for (int m = 0; m < 4; ++m) { const size_t off = (size_t)(row0 + ai * HALF + m * 16) * 1024 + col0;
#pragma unroll
                for (int bj = 0; bj < 2; ++bj) { f32x4 b0, b1;
                    if (BASEB) { const u32x4 r = *(const u32x4*)((const bf16_t*)base + off + bj * HALF);
                        b0[0] = __uint_as_float(r.x << 16); b0[1] = __uint_as_float(r.x & 0xffff0000u); b0[2] = __uint_as_float(r.y << 16); b0[3] = __uint_as_float(r.y & 0xffff0000u);
                        b1[0] = __uint_as_float(r.z << 16); b1[1] = __uint_as_float(r.z & 0xffff0000u); b1[2] = __uint_as_float(r.w << 16); b1[3] = __uint_as_float(r.w & 0xffff0000u); }
                    else { b0 = __builtin_nontemporal_load((const f32x4*)((const float*)base + off + bj * HALF)); b1 = __builtin_nontemporal_load((const f32x4*)((const float*)base + off + bj * HALF + 4)); }
                    const f32x4 o0 = b0 + gv[bj][0] * acc[ai][bj][m][0], o1 = b1 + gv[bj][1] * acc[ai][bj][m][1];
                    u32x4 w; w.x = cvt_pk_bf16(o0[0], o0[1]); w.y = cvt_pk_bf16(o0[2], o0[3]); w.z = cvt_pk_bf16(o1[0], o1[1]); w.w = cvt_pk_bf16(o1[2], o1[3]);
                    *(u32x4*)(out + off + bj * HALF) = w; } }
    }
};
template <class Epi, class Sched, bool ALIGN_EPI = false, bool SP2 = false>
__device__ __forceinline__ void gemm_phase(PG8_LAS unsigned char* lds, const Gemm g, const Sched& S, const Epi& E) {
    int tid_ = threadIdx.x; asm volatile("" : "+v"(tid_));
    const int tid = tid_, wid = __builtin_amdgcn_readfirstlane(tid >> 6), lane = tid & 63, wr = wid >> 2, wc = wid & 3, fr = lane & 15, fq = lane >> 4;
    const int K = g.K, nt = K / BK;
    unsigned voffA[2], voffB[2];
#pragma unroll
    for (int i = 0; i < 2; ++i) { int R, C; stage_rc(tid * 16 + i * 8192, R, C); const int Rb = Epi::PERM ? ((R & ~31) + perm32(R & 31)) : R;
        voffA[i] = (unsigned)(R * K + C) * 2u; voffB[i] = (unsigned)(Rb * K + C) * 2u; }
    const size_t kstep = (size_t)(BK * 2);
    const size_t hstep = (size_t)HALF * K * 2;
    const size_t tstep = 2 * hstep;
    const unsigned ldsw = (unsigned)wid * 1024u;
    const int aoff = lds_byte(wr * 64 + fr, fq * 8), boff = lds_byte(wc * 32 + fr, fq * 8);
#define PG8_SA(b, h) (((b) * 2 + (h)) * HTB)
#define PG8_SB(b, h) ((4 + (b) * 2 + (h)) * HTB)
#define PG8_STAGE(bufoff, gbase, voff) do { _Pragma("unroll") for (int _i = 0; _i < 2; ++_i) \
        __builtin_amdgcn_global_load_lds((const unsigned*)((const char*)(gbase) + (voff)[_i]), (PG8_LAS unsigned*)(lds + (bufoff) + ldsw + _i * 8192), 16, 0, 0); } while (0)
#define PG8_LDA(dst, b, h) do { _Pragma("unroll") for (int m = 0; m < 4; ++m) _Pragma("unroll") for (int k = 0; k < 2; ++k) dst[m][k] = *(const PG8_LAS bf16x8*)(lds + PG8_SA(b, h) + aoff + m * 2048 + k * 1024); } while (0)
#define PG8_LDB(dst, b, h) do { _Pragma("unroll") for (int n = 0; n < 2; ++n) _Pragma("unroll") for (int k = 0; k < 2; ++k) dst[n][k] = *(const PG8_LAS bf16x8*)(lds + PG8_SB(b, h) + boff + n * 2048 + k * 1024); } while (0)
#define PG8_MMA(ai, bj, At, Bt) do { __builtin_amdgcn_s_setprio(1); _Pragma("unroll") for (int m = 0; m < 4; ++m) _Pragma("unroll") for (int n = 0; n < 2; ++n) _Pragma("unroll") for (int k = 0; k < 2; ++k) \
        acc[ai][bj][m][n] = __builtin_amdgcn_mfma_f32_16x16x32_bf16(Bt[n][k], At[m][k], acc[ai][bj][m][n], 0, 0, 0); __builtin_amdgcn_s_setprio(0); } while (0)
#define PG8_WAIT_V(n) asm volatile("s_waitcnt vmcnt(" #n ")" ::: "memory")
#define PG8_WAIT_L(n) asm volatile("s_waitcnt lgkmcnt(" #n ")" ::: "memory")
#define PG8_BAR __builtin_amdgcn_s_barrier()
#define PG8_SCHED __builtin_amdgcn_sched_barrier(0)
    Unit cur, nxt; int ui = 0;
    if (!S.next(0, cur)) return;
    f32x4 acc[2][2][4][2];
#pragma unroll
    for (int a = 0; a < 2; ++a)
#pragma unroll
        for (int b = 0; b < 2; ++b)
#pragma unroll
            for (int m = 0; m < 4; ++m)
#pragma unroll
                for (int n = 0; n < 2; ++n) acc[a][b][m][n] = (f32x4){0.f, 0.f, 0.f, 0.f};
    bf16x8 At[4][2], B0[2][2], B1[2][2];
    const char* cA = (const char*)g.A + (size_t)cur.pm * tstep; const char* cB = (const char*)g.Bt + (size_t)cur.pn * tstep;
    S.a_ready(cur);
    if constexpr (SP2) {
        PG8_STAGE(PG8_SB(0, 0), cB, voffB); PG8_STAGE(PG8_SB(0, 1), cB + hstep, voffB); PG8_STAGE(PG8_SA(0, 0), cA, voffA); PG8_STAGE(PG8_SA(0, 1), cA + hstep, voffA);
        if (wr == 1) PG8_BAR;
        PG8_WAIT_V(2); PG8_BAR;
        PG8_STAGE(PG8_SB(1, 0), cB + kstep, voffB); PG8_STAGE(PG8_SA(1, 0), cA + kstep, voffA); PG8_STAGE(PG8_SB(1, 1), cB + hstep + kstep, voffB);
        PG8_WAIT_V(6); PG8_BAR;
    } else {
        PG8_STAGE(PG8_SB(0, 0), cB, voffB); PG8_STAGE(PG8_SA(0, 0), cA, voffA); PG8_STAGE(PG8_SB(0, 1), cB + hstep, voffB); PG8_STAGE(PG8_SA(0, 1), cA + hstep, voffA);
        if (wr == 1) PG8_BAR;
        PG8_WAIT_V(4); PG8_BAR;
        PG8_STAGE(PG8_SB(1, 0), cB + kstep, voffB); PG8_STAGE(PG8_SA(1, 0), cA + kstep, voffA); PG8_STAGE(PG8_SB(1, 1), cB + hstep + kstep, voffB);
        PG8_WAIT_V(6); PG8_BAR;
    }
    for (;;) {
        const bool has_next = S.next(ui + 1, nxt);
        const char* nA = has_next ? (const char*)g.A + (size_t)nxt.pm * tstep : cA; const char* nB = has_next ? (const char*)g.Bt + (size_t)nxt.pn * tstep : cB;
        for (int t = 0; t < nt; t += 2) {
            const bool last = (t == nt - 2);
            const char* a1 = cA + (size_t)(t + 1) * kstep;
            const char* a2 = last ? nA : cA + (size_t)(t + 2) * kstep; const char* b2 = last ? nB : cB + (size_t)(t + 2) * kstep;
            const char* a3 = a2 + kstep; const char* b3 = b2 + kstep;
            if (last && has_next) S.a_ready(nxt);
            if constexpr (SP2) {
            PG8_LDB(B0, 0, 0); PG8_LDB(B1, 0, 1); PG8_SCHED; PG8_LDA(At, 0, 0); PG8_STAGE(PG8_SA(1, 1), a1 + hstep, voffA);
            PG8_WAIT_V(8); PG8_WAIT_L(0); PG8_BAR; PG8_MMA(0, 0, At, B0); PG8_MMA(0, 1, At, B1); PG8_BAR; PG8_SCHED;
            PG8_LDA(At, 0, 1); PG8_STAGE(PG8_SB(0, 0), b2, voffB); PG8_STAGE(PG8_SB(0, 1), b2 + hstep, voffB); PG8_STAGE(PG8_SA(0, 0), a2, voffA);
            PG8_WAIT_V(8); PG8_WAIT_L(0); PG8_BAR; PG8_MMA(1, 0, At, B0); PG8_MMA(1, 1, At, B1); PG8_BAR; PG8_SCHED;
            PG8_LDB(B0, 1, 0); PG8_LDB(B1, 1, 1); PG8_SCHED; PG8_LDA(At, 1, 0); PG8_STAGE(PG8_SA(0, 1), a2 + hstep, voffA);
            PG8_WAIT_V(8); PG8_WAIT_L(0); PG8_BAR; PG8_MMA(0, 0, At, B0); PG8_MMA(0, 1, At, B1); PG8_BAR; PG8_SCHED;
            PG8_LDA(At, 1, 1); PG8_STAGE(PG8_SB(1, 0), b3, voffB); PG8_STAGE(PG8_SB(1, 1), b3 + hstep, voffB); PG8_STAGE(PG8_SA(1, 0), a3, voffA);
            PG8_WAIT_V(8); PG8_WAIT_L(0); PG8_BAR; PG8_MMA(1, 0, At, B0); PG8_MMA(1, 1, At, B1); PG8_BAR; PG8_SCHED;
            } else {
            PG8_LDB(B0, 0, 0); PG8_SCHED; PG8_LDA(At, 0, 0); PG8_STAGE(PG8_SA(1, 1), a1 + hstep, voffA);
            PG8_WAIT_L(8); PG8_BAR; PG8_WAIT_L(0); PG8_MMA(0, 0, At, B0); PG8_BAR; PG8_SCHED;
            PG8_LDB(B1, 0, 1); PG8_STAGE(PG8_SB(0, 0), b2, voffB);
            PG8_BAR; PG8_WAIT_L(0); PG8_MMA(0, 1, At, B1); PG8_BAR;
            PG8_LDA(At, 0, 1); PG8_STAGE(PG8_SA(0, 0), a2, voffA);
            PG8_BAR; PG8_WAIT_L(0); PG8_MMA(1, 0, At, B0); PG8_BAR; PG8_SCHED;
            PG8_STAGE(PG8_SB(0, 1), b2 + hstep, voffB);
            PG8_WAIT_V(6); PG8_BAR; PG8_MMA(1, 1, At, B1); PG8_BAR;
            PG8_LDB(B0, 1, 0); PG8_SCHED; PG8_LDA(At, 1, 0); PG8_STAGE(PG8_SA(0, 1), a2 + hstep, voffA);
            PG8_WAIT_L(8); PG8_BAR; PG8_WAIT_L(0); PG8_MMA(0, 0, At, B0); PG8_BAR; PG8_SCHED;
            PG8_LDB(B1, 1, 1); PG8_STAGE(PG8_SB(1, 0), b3, voffB);
            PG8_BAR; PG8_WAIT_L(0); PG8_MMA(0, 1, At, B1); PG8_BAR;
            PG8_LDA(At, 1, 1); PG8_STAGE(PG8_SA(1, 0), a3, voffA);
            PG8_BAR; PG8_WAIT_L(0); PG8_MMA(1, 0, At, B0); PG8_BAR; PG8_SCHED;
            PG8_STAGE(PG8_SB(1, 1), b3 + hstep, voffB);
            PG8_WAIT_V(6); PG8_BAR; PG8_MMA(1, 1, At, B1); PG8_BAR;
            }
        }
        if constexpr (ALIGN_EPI) { if (wr == 0) PG8_BAR; }
        if constexpr (!Epi::AFTER_DRAIN) { E(acc, cur, wr, wc, fr, fq); S.done(cur); }
        if (!has_next) break;
#pragma unroll
        for (int a = 0; a < 2; ++a)
#pragma unroll
            for (int b = 0; b < 2; ++b)
#pragma unroll
                for (int m = 0; m < 4; ++m)
#pragma unroll
                    for (int n = 0; n < 2; ++n) acc[a][b][m][n] = (f32x4){0.f, 0.f, 0.f, 0.f};
        cur = nxt; cA = nA; cB = nB; ++ui;
        if constexpr (ALIGN_EPI) { if (wr == 1) PG8_BAR; }
    }
    PG8_WAIT_V(0);
    if constexpr (!ALIGN_EPI) { if (wr == 0) PG8_BAR; }
    PG8_BAR;
    if constexpr (Epi::AFTER_DRAIN) { E.fused(acc, cur, wr, wc, fr, fq, lds, wid, lane); S.done(cur); }
#undef PG8_SA
#undef PG8_SB
#undef PG8_STAGE
#undef PG8_LDA
#undef PG8_LDB
#undef PG8_MMA
#undef PG8_WAIT_V
#undef PG8_WAIT_L
#undef PG8_BAR
#undef PG8_SCHED
}
}
typedef unsigned short bf16_t;
typedef float f32x4 __attribute__((ext_vector_type(4)));
constexpr int NB = 4, SEQ = 8192, CTXL = 256;
constexpr int NX = NB * SEQ, NC = NB * CTXL, NT = NX + NC;
constexpr int DFF = 2816;
constexpr size_t MiB = 1u << 20;
constexpr size_t WS_WIN = 0, WS_WOUT = 8 * MiB, WS_WGU = 10 * MiB, WS_WDN = 21 * MiB, WS_SMALL = 461 * MiB, WS_END = 470 * MiB, WS_H = 32 * MiB, WS_ZQK = 98 * MiB, WS_ZR = 164 * MiB,
                 WS_GQK = 329 * MiB, WS_SST = 395 * MiB, WS_ACT = 98 * MiB;
constexpr size_t SM_MOD = 0, SM_MGATE = 128 * 1024, SM_MCHUNK = 4608 * 1024, SM_NST = 4736 * 1024, SM_MSTATE = 5888 * 1024, SM_GBT = 6016 * 1024, SM_BAR = 7424 * 1024;
constexpr size_t OUT_QK = 0, OUT_GATES = (size_t)NT * 1024 * 2;
constexpr int PITCH = 136, IMG_BYTES = 128 * PITCH * 2;
constexpr int LDS_BYTES = 151552, SMALL_OFF = 4 * IMG_BYTES;
constexpr float EPSN = 1e-6f;
#ifndef P5SEL
#define P5SEL 0
#endif

struct Params {
    const float *x, *c, *ctx, *c_ctx, *w_ada, *b_ada, *g_mix, *w_in, *conv_w, *m_gate_b, *m_norm_g, *g_gate_w, *g_gate_b, *g_norm_g, *w_out, *g_ffn, *w_gu, *w_down, *g_final;
    float* out; unsigned char* ws;
};

#define DI __device__ __forceinline__
#define LAS __attribute__((address_space(3)))
#define XB_TMO      128
#define XB_XCNT(j)  (256  + 64 * (j))
#define XB_XSUB(j)  (1280 + 64 * (j))
#define XB_XGEN(j)  (2304 + 64 * (j))
#define XB_TOP      3328
#define XB_TOPGEN   3392
#define XCD_BAR_WORDS 3456
#define XB_SPIN_CAP (1u << 18)

__device__ __forceinline__ unsigned xb_ld(unsigned* p)              { return __hip_atomic_load(p, __ATOMIC_RELAXED, __HIP_MEMORY_SCOPE_AGENT); }
__device__ __forceinline__ unsigned xb_add(unsigned* p, unsigned v) { return __hip_atomic_fetch_add(p, v, __ATOMIC_RELAXED, __HIP_MEMORY_SCOPE_AGENT); }
__device__ __forceinline__ unsigned xb_xcc_id() { return (unsigned)__builtin_amdgcn_s_getreg((3 << 11) | 20) & 0xFu; }
#define XB_SPIN(cond, bar) do { unsigned _sp = 0; while (cond) { __builtin_amdgcn_s_sleep(1); \
    if ((++_sp & 255u) == 0u) { if (xb_ld(&(bar)[XB_TMO])) break; if (_sp > XB_SPIN_CAP) { atomicAdd(&(bar)[XB_TMO], 1u); break; } } } } while (0)

struct XcdBarrier {
    unsigned* bar; unsigned x;
    volatile LAS unsigned* st;
};

__device__ __forceinline__ XcdBarrier xcd_barrier_post(unsigned* bar, volatile LAS unsigned* st) {
    XcdBarrier b; b.bar = bar; b.x = xb_xcc_id(); b.st = st;
    if (threadIdx.x == 0) (void)xb_add(&bar[XB_XCNT(b.x)], 1u);
    return b;
}
__device__ __forceinline__ void xcd_barrier_complete(unsigned* bar, unsigned x, unsigned& nloc, unsigned& nx) {
    const unsigned G = gridDim.x * gridDim.y * gridDim.z;
    unsigned sum, cnt, mine, sp = 0u;
    for (;;) {
        sum = 0u; cnt = 0u; mine = 0u;
#pragma unroll
        for (unsigned j = 0; j < 16; ++j) { const unsigned c = xb_ld(&bar[XB_XCNT(j)]); sum += c; cnt += (c > 0u) ? 1u : 0u; mine = (j == x) ? c : mine; }
        if (sum == G) break;
        __builtin_amdgcn_s_sleep(1);
        if ((++sp & 255u) == 0u) { if (xb_ld(&bar[XB_TMO])) break; if (sp > XB_SPIN_CAP) { atomicAdd(&bar[XB_TMO], 1u); break; } }
    }
    nloc = mine > 0u ? mine : 1u; nx = cnt > 0u ? cnt : 1u;
}

__device__ __forceinline__ void xcd_barrier(const XcdBarrier& b) {
    asm volatile("s_waitcnt vmcnt(0)" ::: "memory");
    __syncthreads();
    if (threadIdx.x == 0) {
        unsigned* bar = b.bar;
        __builtin_amdgcn_s_waitcnt(0);
        unsigned nloc = b.st[0], nx = b.st[1];
        if (nloc == 0u) { xcd_barrier_complete(bar, b.x, nloc, nx); b.st[0] = nloc; b.st[1] = nx; }
        const unsigned old = xb_add(&bar[XB_XSUB(b.x)], 1u);
        const unsigned gen = old / nloc;
        if (old + 1u == (gen + 1u) * nloc) {
            __builtin_amdgcn_fence(__ATOMIC_RELEASE, "agent");
            asm volatile("s_waitcnt vmcnt(0)" ::: "memory");
            const unsigned og = xb_add(&bar[XB_TOP], 1u);
            const unsigned tg = og / nx;
            if (og + 1u == (tg + 1u) * nx) xb_add(&bar[XB_TOPGEN], 1u);
            else XB_SPIN(xb_ld(&bar[XB_TOPGEN]) == tg, bar);
            __builtin_amdgcn_fence(__ATOMIC_ACQUIRE, "agent");
            xb_add(&bar[XB_XGEN(b.x)], 1u);
            asm volatile("s_waitcnt vmcnt(0)" ::: "memory");
        } else {
            XB_SPIN(xb_ld(&bar[XB_XGEN(b.x)]) == gen, bar);
            __builtin_amdgcn_fence(__ATOMIC_ACQUIRE, "agent");
            asm volatile("s_waitcnt vmcnt(0)" ::: "memory");
        }
    }
    __syncthreads();
}

DI float bf2f(bf16_t v) { return __uint_as_float((unsigned)v << 16); }
DI unsigned f2bfu(float f) { unsigned u = __float_as_uint(f); return (u + 0x7fffu + ((u >> 16) & 1u)) >> 16; }
DI bf16_t f2bf(float f) { return __builtin_bit_cast(bf16_t, (__bf16)f); }
typedef __bf16 bf16x2_t __attribute__((ext_vector_type(2)));
DI unsigned pk2(float lo, float hi) { const bf16x2_t v = {(__bf16)lo, (__bf16)hi}; return __builtin_bit_cast(unsigned, v); }
DI void unpack8(const uint4 r, float (&o)[8]) {
    o[0] = __uint_as_float(r.x << 16); o[1] = __uint_as_float(r.x & 0xffff0000u); o[2] = __uint_as_float(r.y << 16); o[3] = __uint_as_float(r.y & 0xffff0000u);
    o[4] = __uint_as_float(r.z << 16); o[5] = __uint_as_float(r.z & 0xffff0000u); o[6] = __uint_as_float(r.w << 16); o[7] = __uint_as_float(r.w & 0xffff0000u); }
DI uint4 pack8(const float (&o)[8]) { uint4 r; r.x = pk2(o[0], o[1]); r.y = pk2(o[2], o[3]); r.z = pk2(o[4], o[5]); r.w = pk2(o[6], o[7]); return r; }
DI void lds_barrier() { asm volatile("s_waitcnt lgkmcnt(0)" ::: "memory"); __builtin_amdgcn_s_barrier(); asm volatile("" ::: "memory"); }
DI float wave_sum(float v) {
#pragma unroll
    for (int o = 1; o < 64; o <<= 1) v += __shfl_xor(v, o);
    return v; }
DI float wave_max(float v) {
#pragma unroll
    for (int o = 1; o < 64; o <<= 1) v = fmaxf(v, __shfl_xor(v, o));
    return v; }
DI float logsig(float x) { return fminf(x, 0.f) - log1pf(expf(-fabsf(x))); }
DI float sigm(float x) { return __builtin_amdgcn_rcpf(1.0f + __expf(-x)); }
DI float logsig_fast(float x) { return fminf(x, 0.f) - __logf(1.0f + __expf(-fabsf(x))); }

typedef short bf16x8 __attribute__((ext_vector_type(8)));
typedef short s16x4 __attribute__((ext_vector_type(4)));
typedef short v4i16_t __attribute__((ext_vector_type(4)));
typedef float f32x16 __attribute__((ext_vector_type(16)));
#define LAS3 __attribute__((address_space(3)))
struct Own {
    int rbase, cbase;
    static constexpr int NRS = 16;
    DI int row(int idx) const { return rbase + (idx & 3) + 8 * ((idx & 15) >> 2); }
    DI int col(int idx) const { return cbase + 32 * (idx >> 4); }
    static DI int rslot(int idx) { return idx & 15; }
    DI int slotrow(int rs) const { return rbase + (rs & 3) + 8 * (rs >> 2); }
};
DI Own make_own(int tid) { Own o; const int w = tid >> 6, lane = tid & 63; o.rbase = 32 * (w & 3) + 4 * (lane >> 5); o.cbase = 64 * (w >> 2) + (lane & 31); return o; }
DI s16x4 trrd(const bf16_t* p) { return __builtin_bit_cast(s16x4, __builtin_amdgcn_ds_read_tr16_b64_v4i16((LAS3 v4i16_t*)p)); }
template <bool ATR, bool BTR, int NKS = 8> DI void mm128(float (&acc)[32], const bf16_t* A, const bf16_t* B, int tid, int ks0 = 0) {
    const int w = tid >> 6, lane = tid & 63, tr = w & 3, tc0 = 2 * (w >> 2), h = lane >> 5, l31 = lane & 31, blk = (lane >> 4) & 1, q = (lane & 15) >> 2, pq = lane & 3;
    f32x16 c0, c1;
#pragma unroll
    for (int i = 0; i < 16; ++i) { c0[i] = acc[i]; c1[i] = acc[16 + i]; }
    const bf16_t* ap = (ATR ? A + (8 * h + q) * PITCH + 32 * tr + 16 * blk + 4 * pq : A + (32 * tr + l31) * PITCH + 8 * h) + (ATR ? ks0 * 16 * PITCH : ks0 * 16);
    const bf16_t* bp = (BTR ? B + (8 * h + q) * PITCH + 32 * tc0 + 16 * blk + 4 * pq : B + (32 * tc0 + l31) * PITCH + 8 * h) + (BTR ? ks0 * 16 * PITCH : ks0 * 16);
#pragma unroll
    for (int ks = 0; ks < NKS; ++ks) {
        bf16x8 a, b0, b1;
        if (ATR) { const s16x4 lo = trrd(ap + ks * 16 * PITCH), hi = trrd(ap + (ks * 16 + 4) * PITCH); a = __builtin_shufflevector(lo, hi, 0, 1, 2, 3, 4, 5, 6, 7); }
        else a = *(const LAS3 bf16x8*)(ap + ks * 16);
        if (BTR) { const s16x4 lo0 = trrd(bp + ks * 16 * PITCH), hi0 = trrd(bp + (ks * 16 + 4) * PITCH), lo1 = trrd(bp + ks * 16 * PITCH + 32), hi1 = trrd(bp + (ks * 16 + 4) * PITCH + 32);
            b0 = __builtin_shufflevector(lo0, hi0, 0, 1, 2, 3, 4, 5, 6, 7); b1 = __builtin_shufflevector(lo1, hi1, 0, 1, 2, 3, 4, 5, 6, 7); }
        else { b0 = *(const LAS3 bf16x8*)(bp + ks * 16); b1 = *(const LAS3 bf16x8*)(bp + 32 * PITCH + ks * 16); }
        c0 = __builtin_amdgcn_mfma_f32_32x32x16_bf16(a, b0, c0, 0, 0, 0);
        c1 = __builtin_amdgcn_mfma_f32_32x32x16_bf16(a, b1, c1, 0, 0, 0);
    }
#pragma unroll
    for (int i = 0; i < 16; ++i) { acc[i] = c0[i]; acc[16 + i] = c1[i]; }
}
DI void zero32(float (&a)[32]) {
#pragma unroll
    for (int i = 0; i < 32; ++i) a[i] = 0.f; }
DI void load_img(bf16_t* img, const bf16_t* g, size_t gp, int tid) {
#pragma unroll
    for (int i = 0; i < 4; ++i) { const int id = tid + 512 * i, r = id >> 4, c8 = (id & 15) * 8; *(uint4*)(img + r * PITCH + c8) = *(const uint4*)(g + (size_t)r * gp + c8); }
}

DI int chperm(int ch) { return (ch & 10) | ((ch & 1) << 2) | ((ch >> 2) & 1); }
DI void load_img_sw(bf16_t* img, const bf16_t* g, size_t gp, int tid) {
#pragma unroll
    for (int i = 0; i < 4; ++i) { const int id = tid + 512 * i, r = id >> 4, ch = id & 15; *(uint4*)(img + r * PITCH + chperm(ch) * 8) = *(const uint4*)(g + (size_t)r * gp + ch * 8); }
}
DI int src_in(int n) { return n < 2048 ? n : (n < 3584 ? n + 16 : (n < 3600 ? n - 1536 : (n < 3632 ? n : -1))); }
DI int src_gu(int n) { const int pn = n >> 8, bj = (n >> 7) & 1, j = n & 127; return bj * 2816 + pn * 128 + j; }
template <int MAP> DI void transpose_item(const float* W, int Nsrc, int K, bf16_t* WT, int ndest, float* scr, int item, int lane) {
    const int nblk = ndest / 32, kb = item / nblk, nb = item % nblk, k0 = 64 * kb, n0 = 32 * nb;
    const int nn = n0 + (lane & 31); const int sc = MAP == 0 ? nn : (MAP == 1 ? src_in(nn) : src_gu(nn));
#pragma unroll 8
    for (int i = 0; i < 32; ++i) { const int kk = 2 * i + (lane >> 5); scr[kk * 33 + (lane & 31)] = sc >= 0 ? W[(size_t)(k0 + kk) * Nsrc + sc] : 0.f; }
    asm volatile("s_waitcnt lgkmcnt(0)" ::: "memory");
    const int c = lane & 7;
#pragma unroll
    for (int j = 0; j < 4; ++j) { const int n = (lane >> 3) + 8 * j; const float* s = scr + (8 * c) * 33 + n;
        uint4 o; o.x = pk2(s[0 * 33], s[1 * 33]); o.y = pk2(s[2 * 33], s[3 * 33]); o.z = pk2(s[4 * 33], s[5 * 33]); o.w = pk2(s[6 * 33], s[7 * 33]);
        *(uint4*)(WT + (size_t)(n0 + n) * K + k0 + 8 * c) = o; }
    asm volatile("s_waitcnt lgkmcnt(0)" ::: "memory");
}
DI void norm_rows(const float* xsrc, const float* ctxsrc, bf16_t* dst, int nrows, const float* g, const float* mod, int sh_off, int sc_off, int gw, int ngw, int lane) {
    for (int row = gw; row < nrows; row += ngw) {
        const float* src; const float* mrow;
        if (row < NX) { src = xsrc + (size_t)row * 1024; mrow = mod + (row >> 13) * 6144; } else { src = ctxsrc + (size_t)(row - NX) * 1024; mrow = mod + 4 * 6144; }
        f32x4 v[4]; float ss = 0.f;
#pragma unroll
        for (int j = 0; j < 4; ++j) { v[j] = __builtin_nontemporal_load((const f32x4*)src + lane + 64 * j); ss += (v[j].x * v[j].x + v[j].y * v[j].y) + (v[j].z * v[j].z + v[j].w * v[j].w); }
        const float rs = rsqrtf(wave_sum(ss) * (1.0f / 1024.0f) + EPSN);
#pragma unroll
        for (int j = 0; j < 4; ++j) { const int col = 4 * (lane + 64 * j);
            const f32x4 gg = *(const f32x4*)(g + col), sc = *(const f32x4*)(mrow + sc_off + col), sh = *(const f32x4*)(mrow + sh_off + col);
            const f32x4 o = v[j] * rs * gg * (sc + 1.0f) + sh;
            uint2 w; w.x = pk2(o.x, o.y); w.y = pk2(o.z, o.w);
            *(uint2*)(dst + (size_t)row * 1024 + col) = w; }
    }
}
DI void norm_rows_b(const bf16_t* srcb, bf16_t* dst16, float* dst32, int nrows, const float* g, const float* mod, int sh_off, int sc_off, int gw, int ngw, int lane) {
    for (int row0 = gw; row0 < nrows; row0 += 2 * ngw) {
        const int row1 = row0 + ngw; const bool has1 = row1 < nrows; const int r1 = has1 ? row1 : row0;
        uint4 a0 = *(const uint4*)(srcb + (size_t)row0 * 1024 + 8 * lane), a1 = *(const uint4*)(srcb + (size_t)row0 * 1024 + 512 + 8 * lane);
        uint4 b0 = *(const uint4*)(srcb + (size_t)r1 * 1024 + 8 * lane), b1 = *(const uint4*)(srcb + (size_t)r1 * 1024 + 512 + 8 * lane);
#pragma unroll
        for (int q = 0; q < 2; ++q) {
            if (q == 1 && !has1) break;
            const int row = q ? row1 : row0; const float* mrow = mod + (row >> 13) * 6144;
            float v[16]; { float t8[8]; unpack8(q ? b0 : a0, t8);
#pragma unroll
                for (int e = 0; e < 8; ++e) v[e] = t8[e];
                unpack8(q ? b1 : a1, t8);
#pragma unroll
                for (int e = 0; e < 8; ++e) v[8 + e] = t8[e]; }
            float ss = 0.f;
#pragma unroll
            for (int e = 0; e < 16; ++e) ss += v[e] * v[e];
            const float rs = rsqrtf(wave_sum(ss) * (1.0f / 1024.0f) + EPSN);
#pragma unroll
            for (int hh = 0; hh < 2; ++hh) { const int col = 512 * hh + 8 * lane; float o[8];
#pragma unroll
                for (int e4 = 0; e4 < 2; ++e4) { const f32x4 gg = *(const f32x4*)(g + col + 4 * e4);
                    if (dst16) { const f32x4 sc = *(const f32x4*)(mrow + sc_off + col + 4 * e4), sh = *(const f32x4*)(mrow + sh_off + col + 4 * e4);
                        o[4 * e4] = v[8 * hh + 4 * e4] * rs * gg.x * (sc.x + 1.0f) + sh.x; o[4 * e4 + 1] = v[8 * hh + 4 * e4 + 1] * rs * gg.y * (sc.y + 1.0f) + sh.y;
                        o[4 * e4 + 2] = v[8 * hh + 4 * e4 + 2] * rs * gg.z * (sc.z + 1.0f) + sh.z; o[4 * e4 + 3] = v[8 * hh + 4 * e4 + 3] * rs * gg.w * (sc.w + 1.0f) + sh.w; }
                    else { o[4 * e4] = v[8 * hh + 4 * e4] * rs * gg.x; o[4 * e4 + 1] = v[8 * hh + 4 * e4 + 1] * rs * gg.y; o[4 * e4 + 2] = v[8 * hh + 4 * e4 + 2] * rs * gg.z; o[4 * e4 + 3] = v[8 * hh + 4 * e4 + 3] * rs * gg.w; } }
                if (dst16) *(uint4*)(dst16 + (size_t)row * 1024 + col) = pack8(o);
                else { __builtin_nontemporal_store((f32x4){o[0], o[1], o[2], o[3]}, (f32x4*)(dst32 + (size_t)row * 1024 + col)); __builtin_nontemporal_store((f32x4){o[4], o[5], o[6], o[7]}, (f32x4*)(dst32 + (size_t)row * 1024 + col + 4)); } }
        }
    }
}
__global__ void __launch_bounds__(512, 2) mega_fwd(Params p) {
    extern __shared__ __attribute__((aligned(16))) unsigned char lds[];
    cg::grid_group grid = cg::this_grid();
    const int tid = threadIdx.x, lane = tid & 63, wave = __builtin_amdgcn_readfirstlane(tid >> 6);
    const int bid = blockIdx.x, G = gridDim.x;
    const int gw = bid * 8 + wave, ngw = G * 8;
    unsigned char* ws = p.ws;
    bf16_t* Wt_in = (bf16_t*)(ws + WS_WIN); bf16_t* Wt_out = (bf16_t*)(ws + WS_WOUT); bf16_t* Wt_gu = (bf16_t*)(ws + WS_WGU); bf16_t* Wt_dn = (bf16_t*)(ws + WS_WDN);
    float* mod = (float*)(ws + WS_SMALL + SM_MOD); float* mgate = (float*)(ws + WS_SMALL + SM_MGATE); float* mchunk = (float*)(ws + WS_SMALL + SM_MCHUNK);
    bf16_t* xres = (bf16_t*)(ws + WS_GQK);
    float* nst = (float*)(ws + WS_SMALL + SM_NST); float* mstate = (float*)(ws + WS_SMALL + SM_MSTATE); float* gbt = (float*)(ws + WS_SMALL + SM_GBT);
    bf16_t* hbuf = (bf16_t*)(ws + WS_H); bf16_t* mix = hbuf;
    bf16_t* zqk = (bf16_t*)(ws + WS_ZQK); bf16_t* Cst = zqk; bf16_t* zr = (bf16_t*)(ws + WS_ZR); bf16_t* gqk = (bf16_t*)(ws + WS_GQK); bf16_t* Sst = (bf16_t*)(ws + WS_SST);
    bf16_t* act = (bf16_t*)(ws + WS_ACT);
    bf16_t* qk = (bf16_t*)((unsigned char*)p.out + OUT_QK); float* gates = (float*)((unsigned char*)p.out + OUT_GATES);
    bf16_t* R1 = (bf16_t*)(lds); bf16_t* R2 = (bf16_t*)(lds + IMG_BYTES); bf16_t* R3 = (bf16_t*)(lds + 2 * IMG_BYTES); bf16_t* R4 = (bf16_t*)(lds + 3 * IMG_BYTES);
    float* smf = (float*)(lds + SMALL_OFF); float* Himg = (float*)lds;

    unsigned* barw = (unsigned*)(ws + WS_SMALL + SM_BAR); unsigned* modctr = (unsigned*)(ws + WS_SMALL + SM_BAR + 16384 + 128);
    if (G == 0x7fffffff) grid.sync();
    if (tid < 4) ((volatile LAS unsigned*)(lds + LDS_BYTES - 16))[tid] = 0u;
    __syncthreads();
    XcdBarrier bar = xcd_barrier_post(barw, (volatile LAS unsigned*)(lds + LDS_BYTES - 16));
    { int tid = threadIdx.x; asm volatile("" : "+v"(tid)); const int lane = tid & 63, wave = __builtin_amdgcn_readfirstlane(tid >> 6), gw = bid * 8 + wave; (void)lane; (void)gw;
    {
        float* scs = (float*)lds;
        float* red = (float*)(lds + 20480);
        for (int i = tid; i < 5120; i += 512) { const int v = i >> 10, k = i & 1023; const float val = v < 4 ? p.c[v * 1024 + k] : p.c_ctx[k]; scs[i] = val * sigm(val); }
        __syncthreads();
        for (int item = bid; item < 192; item += G) {
            const int col = item * 32 + (lane & 31), kh = lane >> 5;
            float a[5] = {0.f, 0.f, 0.f, 0.f, 0.f};
#pragma unroll 8
            for (int i = 0; i < 64; ++i) { const int k = wave * 128 + 2 * i + kh; const float w = p.w_ada[(size_t)k * 6144 + col];
#pragma unroll
                for (int v = 0; v < 5; ++v) a[v] += scs[v * 1024 + k] * w; }
#pragma unroll
            for (int v = 0; v < 5; ++v) a[v] += __shfl_xor(a[v], 32);
            if (lane < 32) {
#pragma unroll
                for (int v = 0; v < 5; ++v) red[(wave * 5 + v) * 32 + lane] = a[v]; }
            __syncthreads();
            if (tid < 160) { const int v = tid >> 5, cc = tid & 31; float s = 0.f;
#pragma unroll
                for (int w = 0; w < 8; ++w) s += red[(w * 5 + v) * 32 + cc];
                __hip_atomic_store(mod + v * 6144 + item * 32 + cc, s + p.b_ada[item * 32 + cc], __ATOMIC_RELAXED, __HIP_MEMORY_SCOPE_AGENT); }
            asm volatile("s_waitcnt vmcnt(0)" ::: "memory");
            __syncthreads();
            if (tid == 0) __hip_atomic_fetch_add(modctr, 1u, __ATOMIC_RELAXED, __HIP_MEMORY_SCOPE_AGENT);
        }
        float* scr = (float*)(lds + 32768 + wave * 8448);
        constexpr int I_IN = 16 * 120, I_OUT = 16 * 32, I_GU = 16 * 176, I_DN = 44 * 32;
        for (int it = gw; it < I_IN + I_OUT + I_GU + I_DN; it += ngw) {
            int r = it;
            if (r < I_IN) { transpose_item<1>(p.w_in, 3632, 1024, Wt_in, 3840, scr, r, lane); continue; } r -= I_IN;
            if (r < I_OUT) { transpose_item<0>(p.w_out, 1024, 1024, Wt_out, 1024, scr, r, lane); continue; } r -= I_OUT;
            if (r < I_GU) { transpose_item<2>(p.w_gu, 5632, 1024, Wt_gu, 5632, scr, r, lane); continue; } r -= I_GU;
            transpose_item<0>(p.w_down, 1024, 2816, Wt_dn, 1024, scr, r, lane);
        }
    }
    }
    { int tid = threadIdx.x; asm volatile("" : "+v"(tid)); const int lane = tid & 63, wave = __builtin_amdgcn_readfirstlane(tid >> 6), gw = bid * 8 + wave; (void)lane; (void)gw;
    if (tid == 0) { unsigned sp = 0; while (__hip_atomic_load(modctr, __ATOMIC_RELAXED, __HIP_MEMORY_SCOPE_AGENT) < 192u && ++sp < (1u << 22)) __builtin_amdgcn_s_sleep(2);
        __builtin_amdgcn_fence(__ATOMIC_ACQUIRE, "agent"); asm volatile("s_waitcnt vmcnt(0)" ::: "memory"); }
    __syncthreads();
    norm_rows(p.x, p.ctx, hbuf, NT, p.g_mix, mod, 0, 1024, gw, ngw, lane);
    }
    xcd_barrier(bar);
    {
        pg8::Gemm g{hbuf, Wt_in, NT, 3840, 1024}; pg8::StaticOrder S; S.init(NT, 3840, G, bid);
        pg8::EpiZ E{zqk, zr, gates};
        pg8::gemm_phase<pg8::EpiZ, pg8::StaticOrder, true, true>((PG8_LAS unsigned char*)lds, g, S, E);
    }
    xcd_barrier(bar);
    { int tid = threadIdx.x; asm volatile("" : "+v"(tid)); const int lane = tid & 63, wave = __builtin_amdgcn_readfirstlane(tid >> 6), gw = bid * 8 + wave; (void)lane; (void)gw;
    {
        auto conv_item = [&](const bool isx, const int b, const int r, const int seg) {
            const size_t T0 = isx ? (size_t)b * 8192 + r * 64 : (size_t)NX + b * 256 + seg * 64;
            const int ch0 = (tid & 127) * 8, c0 = (tid >> 7) * 16;
            const float oscale = ch0 >= 512 ? 0.08838834764831845f : 1.0f;
            const LAS float* wl = (const LAS float*)(lds + 81920) + ch0;
            const bool rv0 = isx ? (r > 0) : false, rv2 = isx ? (r < 127) : false;
            const bf16_t* l0 = zqk + ((isx ? (size_t)b * 8192 + (size_t)max(r - 1, 0) * 64 : T0)) * 1024 + ch0;
            const bf16_t* l1 = zqk + T0 * 1024 + ch0;
            const bf16_t* l2 = zqk + ((isx ? (size_t)b * 8192 + (size_t)min(r + 1, 127) * 64 : T0)) * 1024 + ch0;
            const int clo = isx ? 0 : -seg * 64, chi = isx ? 63 : 255 - seg * 64;
            uint4 ring[6][3];
#define CONV_LOAD(j) { const int cc_ = min(max(c0 - 1 + (j), clo), chi); ring[(j) % 6][0] = *(const uint4*)(l0 + (ptrdiff_t)cc_ * 1024); ring[(j) % 6][1] = *(const uint4*)(l1 + (ptrdiff_t)cc_ * 1024); ring[(j) % 6][2] = *(const uint4*)(l2 + (ptrdiff_t)cc_ * 1024); }
            CONV_LOAD(0) CONV_LOAD(1) CONV_LOAD(2) CONV_LOAD(3) CONV_LOAD(4)
#pragma unroll
            for (int k = 0; k < 16; ++k) {
                if (k + 5 <= 17) CONV_LOAD(k + 5)
                const int c = c0 + k;
                float acc[8] = {0.f, 0.f, 0.f, 0.f, 0.f, 0.f, 0.f, 0.f};
                const LAS float* wl2 = wl; asm volatile("" : "+v"(wl2));
#pragma unroll
                for (int di = 0; di < 3; ++di) {
                    const bool rv = di == 0 ? rv0 : (di == 2 ? rv2 : true);
                    if (rv) {
#pragma unroll
                        for (int dj = 0; dj < 3; ++dj) {
                            const int cc = c + dj - 1;
                            if (cc >= clo && cc <= chi) {
                                float v[8]; unpack8(ring[(k + dj) % 6][di], v);
                                const f32x4 w0 = *(const LAS f32x4*)(wl2 + (di * 3 + dj) * 1024), w1 = *(const LAS f32x4*)(wl2 + (di * 3 + dj) * 1024 + 4);
                                acc[0] += w0.x * v[0]; acc[1] += w0.y * v[1]; acc[2] += w0.z * v[2]; acc[3] += w0.w * v[3];
                                acc[4] += w1.x * v[4]; acc[5] += w1.y * v[5]; acc[6] += w1.z * v[6]; acc[7] += w1.w * v[7];
                            }
                        }
                    }
                }
#pragma unroll
                for (int e = 0; e < 8; ++e) acc[e] = acc[e] * sigm(acc[e]) * oscale;
                *(uint4*)(qk + (T0 + c) * 1024 + ch0) = pack8(acc);
            }
#undef CONV_LOAD
        };
        auto gprep_item = [&](const int gc) {
            const size_t T0 = (size_t)gc * 64;
            float* glr_s = (float*)lds;
            bf16_t* gq_s = (bf16_t*)(lds + 8192);
            bf16_t* gk_s = (bf16_t*)(lds + 8192 + 32768);
            __syncthreads();
            { const int t = tid >> 3, c4 = (tid & 7) * 4; *(f32x4*)(glr_s + t * 32 + c4) = *(const f32x4*)(gates + (T0 + t) * 64 + 16 + c4); }
#pragma unroll
            for (int i = 0; i < 4; ++i) { const int id = tid + 512 * i, t = id >> 5, c8 = (id & 31) * 8;
                *(uint4*)(gq_s + t * 256 + c8) = *(const uint4*)(zr + (T0 + t) * 2560 + 1024 + c8);
                *(uint4*)(gk_s + t * 256 + c8) = *(const uint4*)(zr + (T0 + t) * 2560 + 1280 + c8); }
            __syncthreads();
            const int dir = tid >> 8, ch = tid & 255;
            f32x4 W[4];
#pragma unroll
            for (int r = 0; r < 4; ++r) { W[r].x = p.g_gate_w[(dir * 16 + 4 * r) * 256 + ch]; W[r].y = p.g_gate_w[(dir * 16 + 4 * r + 1) * 256 + ch]; W[r].z = p.g_gate_w[(dir * 16 + 4 * r + 2) * 256 + ch]; W[r].w = p.g_gate_w[(dir * 16 + 4 * r + 3) * 256 + ch]; }
            const float bias = p.g_gate_b[dir * 256 + ch];
            bf16_t* qo = gqk + (size_t)(dir * 2 + 0) * NT * 256; bf16_t* ko = gqk + (size_t)(dir * 2 + 1) * NT * 256;
            float cum = 0.f;
#pragma unroll 1
            for (int c16 = 0; c16 < 64; c16 += 16) {
                float la[16];
#pragma unroll
                for (int q = 0; q < 16; ++q) {
                    const int pp = c16 + q, t = dir ? 63 - pp : pp;
                    const f32x4* g4 = (const f32x4*)(glr_s + t * 32 + dir * 16);
                    const f32x4 g0 = g4[0], g1 = g4[1], g2 = g4[2], g3 = g4[3];
                    const float x0 = g0.x * W[0].x + g0.y * W[0].y + g0.z * W[0].z + g0.w * W[0].w, x1 = g1.x * W[1].x + g1.y * W[1].y + g1.z * W[1].z + g1.w * W[1].w;
                    const float x2 = g2.x * W[2].x + g2.y * W[2].y + g2.z * W[2].z + g2.w * W[2].w, x3 = g3.x * W[3].x + g3.y * W[3].y + g3.z * W[3].z + g3.w * W[3].w;
                    la[q] = logsig_fast(bias + ((x0 + x1) + (x2 + x3))) * 0.0625f;
                }
#pragma unroll
                for (int q = 0; q < 16; ++q) {
                    const int pp = c16 + q, t = dir ? 63 - pp : pp;
                    cum += la[q];
                    qo[(T0 + t) * 256 + ch] = f2bf(bf2f(gq_s[t * 256 + ch]) * 0.125f * __expf(cum));
                    ko[(T0 + t) * 256 + ch] = f2bf(bf2f(gk_s[t * 256 + ch]) * __expf(-cum));
                }
            }
            gbt[((size_t)dir * 528 + gc) * 256 + ch] = cum;
        };
        auto mprep_item = [&](const int ck) {
            const size_t T0 = ck < 256 ? (size_t)ck * 128 : (size_t)NX + (size_t)(ck - 256) * 128;
            const int dir = wave >> 2, h = wave & 3, icol = dir * 8 + h, fcol = dir * 8 + 4 + h;
            const int p0 = 2 * lane, p1 = 2 * lane + 1, t0 = dir ? 127 - p0 : p0, t1 = dir ? 127 - p1 : p1;
            const float bi = p.m_gate_b[icol], bf = p.m_gate_b[fcol];
            const float i0 = gates[(T0 + t0) * 64 + icol] + bi, i1 = gates[(T0 + t1) * 64 + icol] + bi;
            const float f0 = logsig(gates[(T0 + t0) * 64 + fcol] + bf), f1 = logsig(gates[(T0 + t1) * 64 + fcol] + bf);
            float s = f0 + f1;
#pragma unroll
            for (int o = 1; o < 64; o <<= 1) { const float t = __shfl_up(s, o); if (lane >= o) s += t; }
            const float ex = s - (f0 + f1), bc0 = ex + f0, bc1 = ex + f0 + f1;
            const float btot = __shfl(s, 63);
            const float a0 = i0 - bc0, a1 = i1 - bc1;
            float pm = fmaxf(a0, a1);
#pragma unroll
            for (int o = 1; o < 64; o <<= 1) { const float t = __shfl_up(pm, o); if (lane >= o) pm = fmaxf(pm, t); }
            float pex = __shfl_up(pm, 1); if (lane == 0) pex = -3.0e38f;
            const float ml = wave_max(fmaxf(btot + a0, btot + a1));
            f32x4* mg = (f32x4*)mgate + ((size_t)(dir * 4 + h) * NT + T0);
            mg[t0] = (f32x4){bc0, i0, fmaxf(pex, a0), 0.f}; mg[t1] = (f32x4){bc1, i1, fmaxf(pex, fmaxf(a0, a1)), 0.f};
            if (lane == 0) { float* mc = mchunk + ((size_t)(dir * 4 + h) * 264 + ck) * 2; mc[0] = btot; mc[1] = ml; }
        };
        for (int i = tid; i < 9 * 1024 / 4; i += 512) ((f32x4*)(lds + 81920))[i] = ((const f32x4*)p.conv_w)[i];
        __syncthreads();
        for (int u = bid; u < 1024; u += G) { if (u < 512) conv_item(true, u >> 7, u & 127, 0); else gprep_item(u - 512); }
        for (int v = bid; v < 296; v += G) { if (v < 16) gprep_item(512 + v); else if (v < 32) conv_item(false, (v - 16) >> 2, 0, (v - 16) & 3); else mprep_item(v - 32); }
    }
    }
    xcd_barrier(bar);
    { int tid = threadIdx.x; asm volatile("" : "+v"(tid)); const int lane = tid & 63, wave = __builtin_amdgcn_readfirstlane(tid >> 6), gw = bid * 8 + wave; (void)lane; (void)gw;
    {
        uint4 kraw0, kraw1, kraw2, kraw3, vraw0, vraw1, vraw2, vraw3; float2 mgf0, mgf1, mgf2, mgf3, mgb0, mgb1, mgb2, mgb3; float btf = 0.f, mlf = 0.f, btb = 0.f, mlb = 0.f;
        kraw0 = kraw1 = kraw2 = kraw3 = vraw0 = vraw1 = vraw2 = vraw3 = make_uint4(0u, 0u, 0u, 0u); mgf0 = mgf1 = mgf2 = mgf3 = mgb0 = mgb1 = mgb2 = mgb3 = make_float2(0.f, 0.f);
#define P4A_FETCH(i) { const int id = tid + 512 * (i), r = id >> 4, c8 = (id & 15) * 8; \
            kraw##i = *(const uint4*)(qk + (T0 + r) * 1024 + 512 + h * 128 + c8); vraw##i = *(const uint4*)(zr + (T0 + r) * 2560 + h * 128 + c8); \
            mgf##i = *(const float2*)(mgate + ((size_t)(0 * 4 + h) * NT + T0 + r) * 4); mgb##i = *(const float2*)(mgate + ((size_t)(1 * 4 + h) * NT + T0 + r) * 4); }
#define P4A_STORE(i) { const int id = tid + 512 * (i), r = id >> 4, c8 = (id & 15) * 8; float v[8], o[8]; unpack8(kraw##i, v); \
            const float wf = __expf(btf - mgf##i.x + mgf##i.y - mlf), wb = __expf(btb - mgb##i.x + mgb##i.y - mlb); \
            _Pragma("unroll") for (int e = 0; e < 8; ++e) o[e] = v[e] * wf; \
            *(uint4*)(R1 + r * PITCH + c8) = pack8(o); \
            _Pragma("unroll") for (int e = 0; e < 8; ++e) o[e] = v[e] * wb; \
            *(uint4*)(R3 + r * PITCH + c8) = pack8(o); *(uint4*)(R2 + r * PITCH + c8) = vraw##i; }
        for (int it = bid - G;;) {
            Own own = make_own(threadIdx.x); asm volatile("" : "+v"(own.rbase), "+v"(own.cbase)); int tid = threadIdx.x; asm volatile("" : "+v"(tid));
            const int nx = it + G;
            if (nx < 1056) {
                const int bh = nx / 66, ci = nx % 66, b = bh >> 2, h = bh & 3;
                const int ck = ci < 2 ? 256 + b * 2 + ci : b * 64 + ci - 2;
                const size_t T0 = ck < 256 ? (size_t)ck * 128 : (size_t)NX + (size_t)(ck - 256) * 128;
                P4A_FETCH(0) P4A_FETCH(1) P4A_FETCH(2) P4A_FETCH(3)
                const float* mc0 = mchunk + ((size_t)(0 * 4 + h) * 264 + ck) * 2; const float* mc1 = mchunk + ((size_t)(1 * 4 + h) * 264 + ck) * 2;
                btf = mc0[0]; mlf = mc0[1]; btb = mc1[0]; mlb = mc1[1];
            }
            if (it >= 0) {
                const int bh = it / 66, ci = it % 66;
                const int slf = ci, slb = ci < 2 ? 1 - ci : 67 - ci;
                const int scf = bh, scb = 16 + bh;
                float accf[32], accb[32];
                zero32(accf); mm128<true, true>(accf, R1, R2, tid);
                zero32(accb); mm128<true, true>(accb, R3, R2, tid);
                if (tid < 256) { const int d = tid >> 7, dk = tid & 127; const bf16_t* src = d ? R3 : R1; float sum = 0.f;
                    for (int q = 0; q < 128; ++q) sum += bf2f(src[q * PITCH + dk]);
                    nst[((size_t)(d ? scb : scf) * 66 + (d ? slb : slf)) * 128 + dk] = sum; }
                __syncthreads();
#pragma unroll
                for (int idx = 0; idx < 32; ++idx) { R1[own.row(idx) * PITCH + own.col(idx)] = f2bf(accf[idx]); R3[own.row(idx) * PITCH + own.col(idx)] = f2bf(accb[idx]); }
                __syncthreads();
                { bf16_t* dstf = Cst + ((size_t)scf * 66 + slf) * 16384; bf16_t* dstb = Cst + ((size_t)scb * 66 + slb) * 16384;
#pragma unroll
                    for (int i = 0; i < 4; ++i) { const int id = tid + 512 * i, r = id >> 4, c8 = (id & 15) * 8;
                        *(uint4*)(dstf + r * 128 + c8) = *(const uint4*)(R1 + r * PITCH + c8); *(uint4*)(dstb + r * 128 + c8) = *(const uint4*)(R3 + r * PITCH + c8); } }
            }
            if (nx >= 1056) break;
            __syncthreads();
            P4A_STORE(0) P4A_STORE(1) P4A_STORE(2) P4A_STORE(3)
            __syncthreads();
            it = nx;
        }
    }
    __syncthreads();
    {
        uint4 kf0, kf1, kf2, kf3, kb0, kb1, kb2, kb3, vr0, vr1, vr2, vr3;
        kf0 = kf1 = kf2 = kf3 = kb0 = kb1 = kb2 = kb3 = vr0 = vr1 = vr2 = vr3 = make_uint4(0u, 0u, 0u, 0u);
#define P4G_FETCH(i) { const int id = tid + 512 * (i), r = id >> 4, c8 = (id & 15) * 8, jj = r >> 6; \
            uint4 a = make_uint4(0u, 0u, 0u, 0u), c = make_uint4(0u, 0u, 0u, 0u); \
            if ((c8 >> 6) == jj) { a = *(const uint4*)(ktf + (T0 + r) * 256 + h * 64 + (c8 & 63)); c = *(const uint4*)(ktb + (T0 + r) * 256 + h * 64 + (c8 & 63)); } \
            kf##i = a; kb##i = c; vr##i = *(const uint4*)(zr + (T0 + r) * 2560 + 1536 + h * 128 + c8); }
#define P4G_STORE(i) { const int id = tid + 512 * (i), r = id >> 4, c8 = (id & 15) * 8; \
            *(uint4*)(R1 + r * PITCH + c8) = kf##i; *(uint4*)(R3 + r * PITCH + c8) = kb##i; *(uint4*)(R2 + r * PITCH + c8) = vr##i; }
        for (int it = (G - 1 - bid) - G;;) {
            Own own = make_own(threadIdx.x); asm volatile("" : "+v"(own.rbase), "+v"(own.cbase)); int tid = threadIdx.x; asm volatile("" : "+v"(tid));
            const int nx = it + G;
            if (nx < 1056) {
                const int bh = nx / 66, pi = nx % 66, b = bh >> 2, h = bh & 3;
                const int gc0 = pi < 2 ? 512 + b * 4 + 2 * pi : b * 128 + 2 * (pi - 2);
                const size_t T0 = (size_t)gc0 * 64;
                const bf16_t* ktf = gqk + (size_t)1 * NT * 256; const bf16_t* ktb = gqk + (size_t)3 * NT * 256;
                P4G_FETCH(0) P4G_FETCH(1) P4G_FETCH(2) P4G_FETCH(3)
            }
            if (it >= 0) {
                const int bh = it / 66, pi = it % 66, b = bh >> 2, h = bh & 3;
                const bool isctx = pi < 2; const int c0 = isctx ? 2 * pi : 2 * (pi - 2);
                const int gc0 = isctx ? 512 + b * 4 + c0 : b * 128 + c0;
                const int scf = bh, scb = 16 + bh;
                float accf[32], accb[32];
                const int ksg = 4 * (((tid >> 6) & 3) >> 1);
                zero32(accf); mm128<true, true, 4>(accf, R1, R2, tid, ksg);
                zero32(accb); mm128<true, true, 4>(accb, R3, R2, tid, ksg);
                __syncthreads();
#pragma unroll
                for (int rs = 0; rs < 16; ++rs) { const int m = own.slotrow(rs), jj = m >> 6, dk = m & 63;
                    const float ef = __expf(gbt[((size_t)0 * 528 + gc0 + jj) * 256 + h * 64 + dk]), eb = __expf(gbt[((size_t)1 * 528 + gc0 + jj) * 256 + h * 64 + dk]);
                    R1[m * PITCH + own.col(rs)] = f2bf(accf[rs] * ef); R1[m * PITCH + own.col(16 + rs)] = f2bf(accf[16 + rs] * ef);
                    R3[m * PITCH + own.col(rs)] = f2bf(accb[rs] * eb); R3[m * PITCH + own.col(16 + rs)] = f2bf(accb[16 + rs] * eb); }
                __syncthreads();
#pragma unroll
                for (int i = 0; i < 4; ++i) { const int id = tid + 512 * i, r = id >> 4, c8 = (id & 15) * 8, jj = r >> 6, dk = r & 63, cc = c0 + jj;
                    const int slf = isctx ? cc : 4 + cc, slb = isctx ? 3 - cc : 131 - cc;
                    *(uint4*)(Sst + ((size_t)scf * 132 + slf) * 8192 + dk * 128 + c8) = *(const uint4*)(R1 + r * PITCH + c8);
                    *(uint4*)(Sst + ((size_t)scb * 132 + slb) * 8192 + dk * 128 + c8) = *(const uint4*)(R3 + r * PITCH + c8); }
            }
            if (nx >= 1056) break;
            __syncthreads();
            P4G_STORE(0) P4G_STORE(1) P4G_STORE(2) P4G_STORE(3)
            __syncthreads();
            it = nx;
        }
    }
    }
    xcd_barrier(bar);
    { int tid = threadIdx.x; asm volatile("" : "+v"(tid)); const int lane = tid & 63, wave = __builtin_amdgcn_readfirstlane(tid >> 6), gw = bid * 8 + wave; (void)lane; (void)gw;
    for (int e = bid * 512 + tid; e < 131072; e += G * 512) {
        if (e < 65536) {
            const int sc = e >> 11, off = (e & 2047) * 8, dir = sc >> 4, b = (sc >> 2) & 3, h = sc & 3;
            bf16_t* base = Cst + (size_t)sc * 66 * 16384 + off; const float* mcb = mchunk + (size_t)(dir * 4 + h) * 264 * 2;
            float C[8] = {0.f, 0.f, 0.f, 0.f, 0.f, 0.f, 0.f, 0.f}; float m = -1e30f;
            uint4 ld[11];
#pragma unroll
            for (int u = 0; u < 11; ++u) ld[u] = *(const uint4*)(base + (size_t)u * 16384);
            for (int s0 = 0; s0 < 66; s0 += 11) {
#pragma unroll
                for (int u = 0; u < 11; ++u) { const int slot = s0 + u;
                    const uint4 cur = ld[u];
                    if (slot + 11 < 66) ld[u] = *(const uint4*)(base + (size_t)(slot + 11) * 16384);
                    const int ck = slot < 2 ? 256 + b * 2 + (dir ? 1 - slot : slot) : b * 64 + (dir ? 65 - slot : slot - 2);
                    const float btot = mcb[ck * 2], mloc = mcb[ck * 2 + 1];
                    *(uint4*)(base + (size_t)slot * 16384) = pack8(C);
                    const float mn = fmaxf(m + btot, mloc), a = __expf(m + btot - mn), bb = __expf(mloc - mn);
                    float v[8]; unpack8(cur, v);
#pragma unroll
                    for (int q = 0; q < 8; ++q) C[q] = a * C[q] + bb * v[q];
                    m = mn; }
            }
            if (e < 4096) {
                const int sc2 = e >> 7, dk = e & 127, dir2 = sc2 >> 4, b2 = (sc2 >> 2) & 3, h2 = sc2 & 3;
                float* nb = nst + (size_t)sc2 * 66 * 128 + dk; const float* mcb2 = mchunk + (size_t)(dir2 * 4 + h2) * 264 * 2;
                float n = 0.f, m2 = -1e30f;
                float lq[6]; float2 mq2[6];
#pragma unroll
                for (int u = 0; u < 6; ++u) { lq[u] = nb[u * 128];
                    const int ck0 = u < 2 ? 256 + b2 * 2 + (dir2 ? 1 - u : u) : b2 * 64 + (dir2 ? 65 - u : u - 2); mq2[u] = *(const float2*)(mcb2 + ck0 * 2); }
                for (int s0 = 0; s0 < 66; s0 += 6) {
#pragma unroll
                    for (int u = 0; u < 6; ++u) { const int slot = s0 + u;
                        const float loc = lq[u], btot = mq2[u].x, mloc = mq2[u].y;
                        if (slot + 6 < 66) { const int sn = slot + 6; lq[u] = nb[sn * 128]; const int ckn = b2 * 64 + (dir2 ? 65 - sn : sn - 2); mq2[u] = *(const float2*)(mcb2 + ckn * 2); }
                        nb[slot * 128] = n; if (dk == 0) mstate[sc2 * 66 + slot] = m2;
                        const float mn = fmaxf(m2 + btot, mloc), a = __expf(m2 + btot - mn), bb = __expf(mloc - mn);
                        n = a * n + bb * loc; m2 = mn; }
                }
            }
        } else {
            const int e1 = e - 65536, sc = e1 >> 11, off = (e1 & 2047) * 4, dk = off >> 7, dir = sc >> 4, b = (sc >> 2) & 3, h = sc & 3;
            bf16_t* base = Sst + (size_t)sc * 132 * 8192 + off;
            float S[4] = {0.f, 0.f, 0.f, 0.f};
            uint2 ld[12];
#pragma unroll
            for (int u = 0; u < 12; ++u) ld[u] = *(const uint2*)(base + (size_t)u * 8192);
            for (int s0 = 0; s0 < 132; s0 += 12) {
#pragma unroll
                for (int u = 0; u < 12; ++u) { const int sl = s0 + u;
                    const uint2 cur = ld[u];
                    if (sl + 12 < 132) ld[u] = *(const uint2*)(base + (size_t)(sl + 12) * 8192);
                    const int gc = sl < 4 ? 512 + b * 4 + (dir ? 3 - sl : sl) : b * 128 + (dir ? 131 - sl : sl - 4);
                    const float dec = __expf(gbt[((size_t)dir * 528 + gc) * 256 + h * 64 + dk]);
                    uint2 o; o.x = pk2(S[0], S[1]); o.y = pk2(S[2], S[3]);
                    *(uint2*)(base + (size_t)sl * 8192) = o;
                    S[0] = dec * S[0] + __uint_as_float(cur.x << 16); S[1] = dec * S[1] + __uint_as_float(cur.x & 0xffff0000u);
                    S[2] = dec * S[2] + __uint_as_float(cur.y << 16); S[3] = dec * S[3] + __uint_as_float(cur.y & 0xffff0000u); }
            }
        }
    }
    }
    xcd_barrier(bar);
    { int tid = threadIdx.x; asm volatile("" : "+v"(tid)); const int lane = tid & 63, wave = __builtin_amdgcn_readfirstlane(tid >> 6), gw = bid * 8 + wave; (void)lane; (void)gw;
    for (int it = bid; it < 1024; it += G) {
        int tid = threadIdx.x; asm volatile("" : "+v"(tid));
        const int lane = tid & 63, w = tid >> 6, fr = lane & 15, fq = lane >> 4;
        const int b = it >> 8, h = (it >> 6) & 3, c = it & 63; const size_t T0 = (size_t)b * 8192 + c * 128;
        float* bc = smf; float* ig = smf + 256; float* mt = smf + 512; float* wint = smf + 768; float* qn = smf + 1280; float* nprev = smf + 1792;
        const int scf = (b * 4 + h), scb = 16 + (b * 4 + h), slf = 2 + c, slb = 65 - c;
        __syncthreads();
        load_img(R1, qk + T0 * 1024 + 512 + h * 128, 1024, tid);
        load_img_sw(R2, zr + T0 * 2560 + h * 128, 2560, tid);
        load_img_sw(R3, Cst + ((size_t)scf * 66 + slf) * 16384, 128, tid);
        load_img_sw(R4, Cst + ((size_t)scb * 66 + slb) * 16384, 128, tid);
        bf16x8 qa[4];
#pragma unroll
        for (int ks = 0; ks < 4; ++ks) qa[ks] = *(const bf16x8*)(qk + (T0 + 16 * w + fr) * 1024 + h * 128 + 32 * ks + 8 * fq);
        { const int dir = (tid >> 7) & 1, t = tid & 127, scd = dir ? scb : scf, sld = dir ? slb : slf;
            if (tid < 256) { const f32x4 mg = ((const f32x4*)mgate)[(size_t)(dir * 4 + h) * NT + T0 + t]; const float mprev = mstate[scd * 66 + sld];
                bc[tid] = mg.x; ig[tid] = mg.y; const float mtv = mg.x + fmaxf(mprev, mg.z); mt[tid] = mtv; wint[tid] = __expf(mprev + mg.x - mtv);
                nprev[tid] = nst[((size_t)scd * 66 + sld) * 128 + t]; } }
        uint4 mo0, mo1, mo2, mo3;
        { const bf16_t* mg_ = zr + (T0 + 16 * w) * 2560 + 512 + h * 128;
            mo0 = *(const uint4*)(mg_ + (size_t)(lane >> 3) * 2560 + (lane & 7) * 8); mo1 = *(const uint4*)(mg_ + (size_t)((lane >> 3) + 8) * 2560 + (lane & 7) * 8);
            mo2 = *(const uint4*)(mg_ + (size_t)(lane >> 3) * 2560 + 64 + (lane & 7) * 8); mo3 = *(const uint4*)(mg_ + (size_t)((lane >> 3) + 8) * 2560 + 64 + (lane & 7) * 8); }
        __syncthreads();
        {
            float q0 = 0.f, q1 = 0.f;
#pragma unroll
            for (int ks = 0; ks < 4; ++ks) { float v[8]; unpack8(__builtin_bit_cast(uint4, qa[ks]), v);
                const f32x4 n0 = *(const f32x4*)(nprev + 32 * ks + 8 * fq), n1 = *(const f32x4*)(nprev + 32 * ks + 8 * fq + 4), m0 = *(const f32x4*)(nprev + 128 + 32 * ks + 8 * fq), m1 = *(const f32x4*)(nprev + 128 + 32 * ks + 8 * fq + 4);
                q0 += (v[0] * n0.x + v[1] * n0.y) + (v[2] * n0.z + v[3] * n0.w) + (v[4] * n1.x + v[5] * n1.y) + (v[6] * n1.z + v[7] * n1.w);
                q1 += (v[0] * m0.x + v[1] * m0.y) + (v[2] * m0.z + v[3] * m0.w) + (v[4] * m1.x + v[5] * m1.y) + (v[6] * m1.z + v[7] * m1.w); }
            q0 += __shfl_xor(q0, 16); q0 += __shfl_xor(q0, 32); q1 += __shfl_xor(q1, 16); q1 += __shfl_xor(q1, 32);
            if (fq == 0) { qn[16 * w + fr] = q0; qn[128 + 16 * w + fr] = q1; }
        }
        f32x4 S[8];
#pragma unroll
        for (int ct = 0; ct < 8; ++ct) { S[ct] = (f32x4){0.f, 0.f, 0.f, 0.f};
#pragma unroll
            for (int ks = 0; ks < 4; ++ks) { const bf16x8 kb = *(const LAS3 bf16x8*)(R1 + (16 * ct + fr) * PITCH + 32 * ks + 8 * fq); S[ct] = __builtin_amdgcn_mfma_f32_16x16x32_bf16(qa[ks], kb, S[ct], 0, 0, 0); } }
        __syncthreads();
        bf16_t* Pw = R1 + 16 * w * PITCH;
        f32x4 tot[8];
#pragma unroll
        for (int ct = 0; ct < 8; ++ct) tot[ct] = (f32x4){0.f, 0.f, 0.f, 0.f};
        const int trq = (fr >> 2) * PITCH + 32 * ((fr & 3) >> 1) + 4 * (fr & 1);
#define TRC(ct) (8 * ((((ct) >> 1) & 1) + 2 * ((ct) & 1) + 8 * ((ct) >> 2)))
#pragma unroll
        for (int d = 0; d < 2; ++d) {
            const float* bcd = bc + 128 * d; const float* igd = ig + 128 * d; const float* mtd = mt + 128 * d; const float* wid = wint + 128 * d; const float* qnd = qn + 128 * d;
            float rt[4], rsm[4];
#pragma unroll
            for (int r = 0; r < 4; ++r) { const int t = 16 * w + 4 * fq + r; rt[r] = bcd[t] - mtd[t]; rsm[r] = 0.f; }
#pragma unroll
            for (int ct = 0; ct < 8; ++ct) { const int s = 16 * ct + fr; const float ctm = igd[s] - bcd[s];
#pragma unroll
                for (int r = 0; r < 4; ++r) { const int t = 16 * w + 4 * fq + r; const bool on = d ? (s >= t) : (s <= t);
                    const float pv = on ? S[ct][r] * __expf(rt[r] + ctm) : 0.f; rsm[r] += pv; Pw[(4 * fq + r) * PITCH + s] = f2bf(pv); } }
            float rd[4];
#pragma unroll
            for (int r = 0; r < 4; ++r) { float x = rsm[r]; x += __shfl_xor(x, 1); x += __shfl_xor(x, 2); x += __shfl_xor(x, 4); x += __shfl_xor(x, 8);
                const int t = 16 * w + 4 * fq + r; const float den = wid[t] * qnd[t] + x; rd[r] = 1.0f / fmaxf(fabsf(den), __expf(-mtd[t])); }
            asm volatile("s_waitcnt lgkmcnt(0)" ::: "memory"); __builtin_amdgcn_wave_barrier();
            f32x4 num[8], tmp[8];
#pragma unroll
            for (int ct = 0; ct < 8; ++ct) { num[ct] = (f32x4){0.f, 0.f, 0.f, 0.f}; tmp[ct] = (f32x4){0.f, 0.f, 0.f, 0.f}; }
            const int ksl = d ? (w >> 1) : 0, ksh = d ? 3 : (w >> 1);
            for (int ks = ksl; ks <= ksh; ++ks) {
                const bf16x8 pa = *(const LAS3 bf16x8*)(Pw + fr * PITCH + 32 * ks + 8 * fq);
                const bf16_t* vb = R2 + (32 * ks + 8 * fq) * PITCH + trq;
#pragma unroll
                for (int ct = 0; ct < 8; ++ct) { const s16x4 lo = trrd(vb + TRC(ct)), hi = trrd(vb + 4 * PITCH + TRC(ct));
                    num[ct] = __builtin_amdgcn_mfma_f32_16x16x32_bf16(pa, __builtin_shufflevector(lo, hi, 0, 1, 2, 3, 4, 5, 6, 7), num[ct], 0, 0, 0); }
            }
            const bf16_t* Cd = d ? R4 : R3;
#pragma unroll
            for (int ks = 0; ks < 4; ++ks) {
                const bf16_t* cb = Cd + (32 * ks + 8 * fq) * PITCH + trq;
#pragma unroll
                for (int ct = 0; ct < 8; ++ct) { const s16x4 lo = trrd(cb + TRC(ct)), hi = trrd(cb + 4 * PITCH + TRC(ct));
                    tmp[ct] = __builtin_amdgcn_mfma_f32_16x16x32_bf16(qa[ks], __builtin_shufflevector(lo, hi, 0, 1, 2, 3, 4, 5, 6, 7), tmp[ct], 0, 0, 0); }
            }
#pragma unroll
            for (int r = 0; r < 4; ++r) { const float wv = wid[16 * w + 4 * fq + r];
#pragma unroll
                for (int ct = 0; ct < 8; ++ct) tot[ct][r] += (num[ct][r] + tmp[ct][r] * wv) * rd[r]; }
            asm volatile("" ::: "memory"); __builtin_amdgcn_wave_barrier();
        }
        float rsn[4];
#pragma unroll
        for (int r = 0; r < 4; ++r) { float x = 0.f;
#pragma unroll
            for (int ct = 0; ct < 8; ++ct) x += tot[ct][r] * tot[ct][r];
            x += __shfl_xor(x, 1); x += __shfl_xor(x, 2); x += __shfl_xor(x, 4); x += __shfl_xor(x, 8);
            rsn[r] = rsqrtf(x * (1.0f / 128.0f) + EPSN); }
        float* Hw = (float*)Pw;
#pragma unroll
        for (int hf = 0; hf < 2; ++hf) {
#pragma unroll
            for (int c4 = 0; c4 < 4; ++c4)
#pragma unroll
                for (int r = 0; r < 4; ++r) Hw[(4 * fq + r) * 68 + 16 * c4 + fr] = tot[4 * hf + c4][r] * rsn[r];
            asm volatile("s_waitcnt lgkmcnt(0)" ::: "memory"); __builtin_amdgcn_wave_barrier();
#pragma unroll
            for (int i = 0; i < 2; ++i) { const int pz = lane + 64 * i, row = pz >> 3, c8 = (pz & 7) * 8, dv0 = 64 * hf + c8;
                float mo[8]; unpack8(hf == 0 ? (i == 0 ? mo0 : mo1) : (i == 0 ? mo2 : mo3), mo); float o[8];
                const f32x4 g0 = *(const f32x4*)(p.m_norm_g + h * 128 + dv0), g1 = *(const f32x4*)(p.m_norm_g + h * 128 + dv0 + 4);
                const f32x4 h0 = *(const f32x4*)(Hw + row * 68 + c8), h1 = *(const f32x4*)(Hw + row * 68 + c8 + 4);
                o[0] = h0.x * g0.x * sigm(mo[0]); o[1] = h0.y * g0.y * sigm(mo[1]); o[2] = h0.z * g0.z * sigm(mo[2]); o[3] = h0.w * g0.w * sigm(mo[3]);
                o[4] = h1.x * g1.x * sigm(mo[4]); o[5] = h1.y * g1.y * sigm(mo[5]); o[6] = h1.z * g1.z * sigm(mo[6]); o[7] = h1.w * g1.w * sigm(mo[7]);
                *(uint4*)(mix + (T0 + 16 * w + row) * 1024 + h * 128 + dv0) = pack8(o); }
            asm volatile("s_waitcnt lgkmcnt(0)" ::: "memory"); __builtin_amdgcn_wave_barrier();
        }
    }
    for (int it = 1024 + bid; it < 2048; it += G) {
        Own own = make_own(threadIdx.x); asm volatile("" : "+v"(own.rbase), "+v"(own.cbase)); int tid = threadIdx.x; asm volatile("" : "+v"(tid));
        {
            const int i2 = it - 1024, b = i2 >> 8, h = (i2 >> 6) & 3, pp = i2 & 63; const size_t T0 = (size_t)b * 8192 + pp * 128;
            const int scf = b * 4 + h, scb = 16 + b * 4 + h, c0 = 2 * pp, c1 = 2 * pp + 1;
            const bf16_t* qf = gqk + (size_t)0 * NT * 256; const bf16_t* kf = gqk + (size_t)1 * NT * 256; const bf16_t* qb = gqk + (size_t)2 * NT * 256; const bf16_t* kb = gqk + (size_t)3 * NT * 256;
            __syncthreads();
#pragma unroll
            for (int i = 0; i < 4; ++i) { const int id = tid + 512 * i, r = id >> 4, c8 = (id & 15) * 8, jj = r >> 6; const bool on = (c8 >> 6) == jj; const size_t go = (T0 + r) * 256 + h * 64 + (c8 & 63);
                uint4 va = make_uint4(0u, 0u, 0u, 0u), vb = va, vc = va, vd = va;
                if (on) { va = *(const uint4*)(qf + go); vb = *(const uint4*)(kf + go); vc = *(const uint4*)(qb + go); vd = *(const uint4*)(kb + go); }
                *(uint4*)(R1 + r * PITCH + c8) = va; *(uint4*)(R2 + r * PITCH + c8) = vb; *(uint4*)(R3 + r * PITCH + c8) = vc; *(uint4*)(R4 + r * PITCH + c8) = vd; }
            uint4 pa0, pa1, pa2, pa3, pb0, pb1, pb2, pb3;
#define P5G_FETCH(x0, x1, x2, x3, src, gp) { const bf16_t* g_ = (src) + (size_t)(tid >> 4) * (gp) + (tid & 15) * 8; x0 = *(const uint4*)(g_); x1 = *(const uint4*)(g_ + (size_t)32 * (gp)); x2 = *(const uint4*)(g_ + (size_t)64 * (gp)); x3 = *(const uint4*)(g_ + (size_t)96 * (gp)); }
#define P5G_STORE(img, x0, x1, x2, x3) { bf16_t* i_ = (img) + (tid >> 4) * PITCH + (tid & 15) * 8; *(uint4*)(i_) = x0; *(uint4*)(i_ + 32 * PITCH) = x1; *(uint4*)(i_ + 64 * PITCH) = x2; *(uint4*)(i_ + 96 * PITCH) = x3; }
            P5G_FETCH(pa0, pa1, pa2, pa3, zr + T0 * 2560 + 1536 + h * 128, 2560)
            __syncthreads();
            float Sf[32], Sb[32]; zero32(Sf); zero32(Sb);
            const int ksg = 4 * (((tid >> 6) & 3) >> 1);
            mm128<false, false, 4>(Sf, R1, R2, tid, ksg);
            mm128<false, false, 4>(Sb, R3, R4, tid, ksg);
            __syncthreads();
#pragma unroll
            for (int idx = 0; idx < 32; ++idx) { const int tt = own.row(idx), s = own.col(idx); R2[tt * PITCH + s] = f2bf((s <= tt ? Sf[idx] : 0.f) + (s >= tt ? Sb[idx] : 0.f)); }
            P5G_STORE(R4, pa0, pa1, pa2, pa3)
            {
                const int dk0 = tid >> 4, c8 = (tid & 15) * 8;
                const bf16_t* sf0 = Sst + ((size_t)scf * 132 + 4 + c0) * 8192; const bf16_t* sf1 = Sst + ((size_t)scf * 132 + 4 + c1) * 8192;
                const bf16_t* sb0 = Sst + ((size_t)scb * 132 + 131 - c0) * 8192; const bf16_t* sb1 = Sst + ((size_t)scb * 132 + 131 - c1) * 8192;
                pa0 = *(const uint4*)(sf0 + dk0 * 128 + c8); pa1 = *(const uint4*)(sf0 + (dk0 + 32) * 128 + c8); pa2 = *(const uint4*)(sf1 + dk0 * 128 + c8); pa3 = *(const uint4*)(sf1 + (dk0 + 32) * 128 + c8);
                pb0 = *(const uint4*)(sb0 + dk0 * 128 + c8); pb1 = *(const uint4*)(sb0 + (dk0 + 32) * 128 + c8); pb2 = *(const uint4*)(sb1 + dk0 * 128 + c8); pb3 = *(const uint4*)(sb1 + (dk0 + 32) * 128 + c8); }
            __syncthreads();
            float tot[32]; zero32(tot);
            mm128<false, true, 4>(tot, R2, R4, tid, ksg);
            __syncthreads();
            P5G_STORE(R2, pa0, pa1, pa2, pa3) P5G_STORE(R4, pb0, pb1, pb2, pb3)
            { const bf16_t* g_ = zr + (T0 + (tid >> 2)) * 2560 + 2048 + h * 128 + (tid & 3) * 32; pa0 = *(const uint4*)(g_); pa1 = *(const uint4*)(g_ + 8); pa2 = *(const uint4*)(g_ + 16); pa3 = *(const uint4*)(g_ + 24); }
            __syncthreads();
            mm128<false, true, 4>(tot, R1, R2, tid, ksg);
            mm128<false, true, 4>(tot, R3, R4, tid, ksg);
            __syncthreads();
#pragma unroll
            for (int idx = 0; idx < 32; ++idx) Himg[own.row(idx) * 132 + own.col(idx)] = tot[idx];
            __syncthreads();
            { const int tr = tid >> 2, part = tid & 3; float ss = 0.f;
#pragma unroll
                for (int j = 0; j < 8; ++j) { const f32x4 v = *(const f32x4*)(Himg + tr * 132 + part * 32 + 4 * j); ss += (v.x * v.x + v.y * v.y) + (v.z * v.z + v.w * v.w); }
                ss += __shfl_xor(ss, 1); ss += __shfl_xor(ss, 2);
                const float rs = rsqrtf(ss * (1.0f / 128.0f) + EPSN);
#pragma unroll
                for (int j8 = 0; j8 < 4; ++j8) { const int col = part * 32 + j8 * 8;
                    float gr[8]; unpack8(j8 == 0 ? pa0 : (j8 == 1 ? pa1 : (j8 == 2 ? pa2 : pa3)), gr); float o[8];
                    const f32x4 g0 = *(const f32x4*)(p.g_norm_g + h * 128 + col), g1 = *(const f32x4*)(p.g_norm_g + h * 128 + col + 4);
                    const f32x4 h0 = *(const f32x4*)(Himg + tr * 132 + col), h1 = *(const f32x4*)(Himg + tr * 132 + col + 4);
                    o[0] = h0.x * rs * g0.x * (gr[0] * sigm(gr[0])); o[1] = h0.y * rs * g0.y * (gr[1] * sigm(gr[1])); o[2] = h0.z * rs * g0.z * (gr[2] * sigm(gr[2])); o[3] = h0.w * rs * g0.w * (gr[3] * sigm(gr[3]));
                    o[4] = h1.x * rs * g1.x * (gr[4] * sigm(gr[4])); o[5] = h1.y * rs * g1.y * (gr[5] * sigm(gr[5])); o[6] = h1.z * rs * g1.z * (gr[6] * sigm(gr[6])); o[7] = h1.w * rs * g1.w * (gr[7] * sigm(gr[7]));
                    *(uint4*)(mix + (T0 + tr) * 1024 + 512 + h * 128 + col) = pack8(o); } }
        }
    }
    __syncthreads();
    }
    xcd_barrier(bar);
    {
        pg8::Gemm g{mix, Wt_out, NX, 1024, 1024}; pg8::StaticOrder S; S.init(NX, 1024, G, bid);
        pg8::EpiResB<false> E{p.x, xres, mod, 2048};
        pg8::gemm_phase<pg8::EpiResB<false>, pg8::StaticOrder, true, true>((PG8_LAS unsigned char*)lds, g, S, E);
    }
    xcd_barrier(bar);
    { int tid = threadIdx.x; asm volatile("" : "+v"(tid)); const int lane = tid & 63, wave = __builtin_amdgcn_readfirstlane(tid >> 6), gw = bid * 8 + wave; (void)lane; (void)gw;
    norm_rows_b(xres, hbuf, nullptr, NX, p.g_ffn, mod, 3072, 4096, gw, ngw, lane);
    }
    xcd_barrier(bar);
    {
        pg8::Gemm g{hbuf, Wt_gu, NX, 5632, 1024}; pg8::StaticOrder S; S.init(NX, 5632, G, bid);
        pg8::EpiGU E{act};
        pg8::gemm_phase<pg8::EpiGU, pg8::StaticOrder, true, true>((PG8_LAS unsigned char*)lds, g, S, E);
    }
    xcd_barrier(bar);
    {
        pg8::Gemm g{act, Wt_dn, NX, 1024, DFF}; pg8::StaticOrder S; S.init(NX, 1024, G, bid);
        pg8::EpiResB<true> E{xres, xres, mod, 5120};
        pg8::gemm_phase<pg8::EpiResB<true>, pg8::StaticOrder, true, true>((PG8_LAS unsigned char*)lds, g, S, E);
    }
    xcd_barrier(bar);
    { int tid = threadIdx.x; asm volatile("" : "+v"(tid)); const int lane = tid & 63, wave = __builtin_amdgcn_readfirstlane(tid >> 6), gw = bid * 8 + wave; (void)lane; (void)gw;
    norm_rows_b(xres, nullptr, p.out, NX, p.g_final, mod, 0, 0, gw, ngw, lane);
    }
}

extern "C" void kernel_launch(void* const* d_in, const int* in_sizes, int n_in, void* d_out, int out_size, void* d_ws, size_t ws_size, hipStream_t stream) {
    static int grid = 0;
    if (grid == 0) {
        if (n_in != 19 || out_size != NX * 1024 || ws_size < WS_END) { fprintf(stderr, "kernel_launch: unexpected shapes (n_in %d out %d ws %zu)\n", n_in, out_size, ws_size); grid = -1; return; }
        int dev = 0, cus = 0, per_cu = 0;
        hipGetDevice(&dev); hipDeviceGetAttribute(&cus, hipDeviceAttributeMultiprocessorCount, dev);
        if (hipFuncSetAttribute((const void*)mega_fwd, hipFuncAttributeMaxDynamicSharedMemorySize, LDS_BYTES) != hipSuccess) { fprintf(stderr, "kernel_launch: hipFuncSetAttribute failed\n"); grid = -1; return; }
        if (hipOccupancyMaxActiveBlocksPerMultiprocessor(&per_cu, (const void*)mega_fwd, 512, LDS_BYTES) != hipSuccess || per_cu < 1) { fprintf(stderr, "kernel_launch: occupancy query gave %d\n", per_cu); per_cu = 1; }
        (void)hipGetLastError();
        grid = cus * 1;
        if (grid <= 0) grid = 256;
    }
    if (grid < 0) return;
    if (hipMemsetAsync((unsigned char*)d_ws + WS_SMALL + SM_BAR, 0, 16384 + 256, stream) != hipSuccess) { fprintf(stderr, "kernel_launch: memset of the barrier words failed\n"); return; }
    Params p{};
    const float** pp = (const float**)&p;
    for (int i = 0; i < 19; ++i) pp[i] = (const float*)d_in[i];
    p.out = (float*)d_out; p.ws = (unsigned char*)d_ws;
    void* args[] = {&p};
    hipError_t e = hipLaunchCooperativeKernel((const void*)mega_fwd, dim3(grid), dim3(512), args, LDS_BYTES, stream);
    if (e != hipSuccess) fprintf(stderr, "cooperative launch failed: %s (grid %d)\n", hipGetErrorString(e), grid);
}
```

```cpp
#include <hip/hip_runtime.h>
#include <hip/hip_cooperative_groups.h>
#include <cstdio>
#include <cstdint>
namespace cg = cooperative_groups;
namespace pg8 {
#define PG8_LAS __attribute__((address_space(3)))
typedef unsigned short bf16_t;
typedef short bf16x8 __attribute__((ext_vector_type(8)));
typedef float f32x4 __attribute__((ext_vector_type(4)));
typedef unsigned u32x4 __attribute__((ext_vector_type(4)));
constexpr int BM = 256, BK = 64, HALF = 128, HTB = HALF * BK * 2  , STAGE_BYTES = 8 * HTB, NXCD = 8, WGM = 8;

__host__ __device__ __forceinline__ int lds_byte(int r, int c) { const int st = (r >> 4) * 2 + (c >> 5), rr = r & 15, cc = c & 31, ob = rr * 64 + cc * 2; return st * 1024 + (ob ^ (((ob >> 9) & 1) << 5)); }
__host__ __device__ __forceinline__ void stage_rc(int b, int& R, int& C) { const int st = b / 1024, sb = b % 1024, swz = sb ^ (((sb >> 9) & 1) << 5); R = (st >> 1) * 16 + swz / 64; C = (st & 1) * 32 + (swz % 64) / 2; }
__host__ __device__ __forceinline__ int perm32(int rho) { const int n = rho >> 4, i = rho & 15; return 8 * (i >> 2) + 4 * n + (i & 3); }

struct Unit { int pm, pn; };
struct Gemm { const bf16_t* A; const bf16_t* Bt; int M, N, K; };

struct StaticOrder {
    int nM, nN, nwg, G, c, wgm;
    __host__ __device__ void init(int M, int N, int G_, int c_, int wgm_ = WGM) { nM = M / BM; nN = N / BM; nwg = nM * nN; G = G_; c = c_; wgm = wgm_; }
    __host__ __device__ bool next(int i, Unit& u) const {
        const long L = (long)i * G + c; if (L >= nwg) return false;
        int wgid = (int)L; { const int q = nwg / NXCD, r = nwg % NXCD, xcd = wgid % NXCD, off = wgid / NXCD; wgid = (xcd < r ? xcd * (q + 1) : r * (q + 1) + (xcd - r) * q) + off; }
        const int nig = wgm * nN, gid = wgid / nig, fm = gid * wgm, gsz = (nM - fm) < wgm ? (nM - fm) : wgm;
        u.pm = fm + ((wgid % nig) % gsz); u.pn = (wgid % nig) / gsz; return true;
    }
    __device__ __forceinline__ void a_ready(const Unit&) const {}
    __device__ __forceinline__ void done(const Unit&) const {}
};

__device__ __forceinline__ unsigned cvt_pk_bf16(float lo, float hi) { unsigned r; asm volatile("v_cvt_pk_bf16_f32 %0, %1, %2" : "=v"(r) : "v"(lo), "v"(hi)); return r; }
typedef float f32x2 __attribute__((ext_vector_type(2)));
typedef float f32x4e __attribute__((ext_vector_type(4)));
__device__ __forceinline__ float silu_f(float a) { return a * __builtin_amdgcn_rcpf(1.0f + __expf(-a)); }
struct EpiZ {
    static constexpr bool PERM = true, AFTER_DRAIN = false;
    bf16_t* zqk; bf16_t* zr; float* gates;
    __device__ __forceinline__ void operator()(const f32x4 (&acc)[2][2][4][2], const Unit& u, int wr, int wc, int fr, int fq) const {
        const int row0 = u.pm * BM + wr * 64 + fr;
        if (u.pn < 14) {
            bf16_t* base; int ldc, colt;
            if (u.pn < 4) { base = zqk; ldc = 1024; colt = u.pn * 256; } else { base = zr; ldc = 2560; colt = (u.pn - 4) * 256; }
            const int col0 = colt + wc * 32 + 8 * fq;
#pragma unroll
            for (int ai = 0; ai < 2; ++ai)
#pragma unroll
                for (int m = 0; m < 4; ++m) { bf16_t* rowp = base + (size_t)(row0 + ai * HALF + m * 16) * ldc + col0;
#pragma unroll
                    for (int bj = 0; bj < 2; ++bj) { const f32x4 v0 = acc[ai][bj][m][0], v1 = acc[ai][bj][m][1];
                        u32x4 w; w.x = cvt_pk_bf16(v0[0], v0[1]); w.y = cvt_pk_bf16(v0[2], v0[3]); w.z = cvt_pk_bf16(v1[0], v1[1]); w.w = cvt_pk_bf16(v1[2], v1[3]);
                        __builtin_nontemporal_store(w, (u32x4*)(rowp + bj * HALF)); } }
        } else if (wc < 2) {
#pragma unroll
            for (int ai = 0; ai < 2; ++ai)
#pragma unroll
                for (int m = 0; m < 4; ++m) { float* rowp = gates + (size_t)(row0 + ai * HALF + m * 16) * 64 + wc * 32 + 8 * fq;
                    *(f32x4*)(rowp) = acc[ai][0][m][0]; *(f32x4*)(rowp + 4) = acc[ai][0][m][1]; }
        }
    }
};
struct EpiRes {
    static constexpr bool PERM = false, AFTER_DRAIN = false;
    const float* base; float* out; const float* mod; int goff;
    __device__ __forceinline__ void operator()(const f32x4 (&acc)[2][2][4][2], const Unit& u, int wr, int wc, int fr, int fq) const {
        const int row0 = u.pm * BM + wr * 64 + fr, b = u.pm >> 5;
        const int col0 = u.pn * BM + wc * 32 + 4 * fq;
        f32x4 gv[2][2];
#pragma unroll
        for (int bj = 0; bj < 2; ++bj)
#pragma unroll
            for (int n = 0; n < 2; ++n) gv[bj][n] = *(const f32x4*)(mod + b * 6144 + goff + col0 + bj * HALF + n * 16);
#pragma unroll
        for (int ai = 0; ai < 2; ++ai)
#pragma unroll
            for (int m = 0; m < 4; ++m) { const size_t off = (size_t)(row0 + ai * HALF + m * 16) * 1024 + col0;
#pragma unroll
                for (int bj = 0; bj < 2; ++bj)
#pragma unroll
                    for (int n = 0; n < 2; ++n) { const f32x4 bs = *(const f32x4*)(base + off + bj * HALF + n * 16);
                        *(f32x4*)(out + off + bj * HALF + n * 16) = bs + gv[bj][n] * acc[ai][bj][m][n]; } }
    }
};
struct EpiGU {
    static constexpr bool PERM = true, AFTER_DRAIN = false;
    bf16_t* act;
    __device__ __forceinline__ void operator()(const f32x4 (&acc)[2][2][4][2], const Unit& u, int wr, int wc, int fr, int fq) const {
        const int row0 = u.pm * BM + wr * 64 + fr, col0 = u.pn * HALF + wc * 32 + 8 * fq;
#pragma unroll
        for (int ai = 0; ai < 2; ++ai)
#pragma unroll
            for (int m = 0; m < 4; ++m) { bf16_t* rowp = act + (size_t)(row0 + ai * HALF + m * 16) * 2816 + col0;
                const f32x4 a0 = acc[ai][0][m][0], a1 = acc[ai][0][m][1], g0 = acc[ai][1][m][0], g1 = acc[ai][1][m][1];
                u32x4 w; w.x = cvt_pk_bf16(silu_f(a0[0]) * g0[0], silu_f(a0[1]) * g0[1]); w.y = cvt_pk_bf16(silu_f(a0[2]) * g0[2], silu_f(a0[3]) * g0[3]);
                w.z = cvt_pk_bf16(silu_f(a1[0]) * g1[0], silu_f(a1[1]) * g1[1]); w.w = cvt_pk_bf16(silu_f(a1[2]) * g1[2], silu_f(a1[3]) * g1[3]);
                __builtin_nontemporal_store(w, (u32x4*)(rowp)); }
    }
};
template <bool BASEB> struct EpiResB {
    static constexpr bool PERM = true, AFTER_DRAIN = false;
    const void* base; bf16_t* out; const float* mod; int goff;
    __device__ __forceinline__ void operator()(const f32x4 (&acc)[2][2][4][2], const Unit& u, int wr, int wc, int fr, int fq) const {
        const int row0 = u.pm * BM + wr * 64 + fr, b = u.pm >> 5;
        const int col0 = u.pn * BM + wc * 32 + 8 * fq;
        f32x4 gv[2][2];
#pragma unroll
        for (int bj = 0; bj < 2; ++bj)
#pragma unroll
            for (int n = 0; n < 2; ++n) gv[bj][n] = *(const f32x4*)(mod + b * 6144 + goff + col0 + bj * HALF + 4 * n);
#pragma unroll
        for (int ai = 0; ai < 2; ++ai)
#pragma unroll
            for (int m = 0; m < 4; ++m) { const size_t off = (size_t)(row0 + ai * HALF + m * 16) * 1024 + col0;
#pragma unroll
                for (int bj = 0; bj < 2; ++bj) { f32x4 b0, b1;
                    if (BASEB) { const u32x4 r = *(const u32x4*)((const bf16_t*)base + off + bj * HALF);
                        b0[0] = __uint_as_float(r.x << 16); b0[1] = __uint_as_float(r.x & 0xffff0000u); b0[2] = __uint_as_float(r.y << 16); b0[3] = __uint_as_float(r.y & 0xffff0000u);
                        b1[0] = __uint_as_float(r.z << 16); b1[1] = __uint_as_float(r.z & 0xffff0000u); b1[2] = __uint_as_float(r.w << 16); b1[3] = __uint_as_float(r.w & 0xffff0000u); }
                    else { b0 = *(const f32x4*)((const float*)base + off + bj * HALF); b1 = *(const f32x4*)((const float*)base + off + bj * HALF + 4); }
                    const f32x4 o0 = b0 + gv[bj][0] * acc[ai][bj][m][0], o1 = b1 + gv[bj][1] * acc[ai][bj][m][1];
                    u32x4 w; w.x = cvt_pk_bf16(o0[0], o0[1]); w.y = cvt_pk_bf16(o0[2], o0[3]); w.z = cvt_pk_bf16(o1[0], o1[1]); w.w = cvt_pk_bf16(o1[2], o1[3]);
                    *(u32x4*)(out + off + bj * HALF) = w; } }
    }
};
template <class Epi, class Sched, bool ALIGN_EPI = false, bool SP2 = false>
__device__ __forceinline__ void gemm_phase(PG8_LAS unsigned char* lds, const Gemm g, const Sched& S, const Epi& E) {
    int tid_ = threadIdx.x; asm volatile("" : "+v"(tid_));
    const int tid = tid_, wid = __builtin_amdgcn_readfirstlane(tid >> 6), lane = tid & 63, wr = wid >> 2, wc = wid & 3, fr = lane & 15, fq = lane >> 4;
    const int K = g.K, nt = K / BK;
    unsigned voffA[2], voffB[2];
#pragma unroll
    for (int i = 0; i < 2; ++i) { int R, C; stage_rc(tid * 16 + i * 8192, R, C); const int Rb = Epi::PERM ? ((R & ~31) + perm32(R & 31)) : R;
        voffA[i] = (unsigned)(R * K + C) * 2u; voffB[i] = (unsigned)(Rb * K + C) * 2u; }
    const size_t kstep = (size_t)(BK * 2);
    const size_t hstep = (size_t)HALF * K * 2;
    const size_t tstep = 2 * hstep;
    const unsigned ldsw = (unsigned)wid * 1024u;
    const int aoff = lds_byte(wr * 64 + fr, fq * 8), boff = lds_byte(wc * 32 + fr, fq * 8);
#define PG8_SA(b, h) (((b) * 2 + (h)) * HTB)
#define PG8_SB(b, h) ((4 + (b) * 2 + (h)) * HTB)
#define PG8_STAGE(bufoff, gbase, voff) do { _Pragma("unroll") for (int _i = 0; _i < 2; ++_i) \
        __builtin_amdgcn_global_load_lds((const unsigned*)((const char*)(gbase) + (voff)[_i]), (PG8_LAS unsigned*)(lds + (bufoff) + ldsw + _i * 8192), 16, 0, 0); } while (0)
#define PG8_LDA(dst, b, h) do { _Pragma("unroll") for (int m = 0; m < 4; ++m) _Pragma("unroll") for (int k = 0; k < 2; ++k) dst[m][k] = *(const PG8_LAS bf16x8*)(lds + PG8_SA(b, h) + aoff + m * 2048 + k * 1024); } while (0)
#define PG8_LDB(dst, b, h) do { _Pragma("unroll") for (int n = 0; n < 2; ++n) _Pragma("unroll") for (int k = 0; k < 2; ++k) dst[n][k] = *(const PG8_LAS bf16x8*)(lds + PG8_SB(b, h) + boff + n * 2048 + k * 1024); } while (0)
#define PG8_MMA(ai, bj, At, Bt) do { __builtin_amdgcn_s_setprio(1); _Pragma("unroll") for (int m = 0; m < 4; ++m) _Pragma("unroll") for (int n = 0; n < 2; ++n) _Pragma("unroll") for (int k = 0; k < 2; ++k) \
        acc[ai][bj][m][n] = __builtin_amdgcn_mfma_f32_16x16x32_bf16(Bt[n][k], At[m][k], acc[ai][bj][m][n], 0, 0, 0); __builtin_amdgcn_s_setprio(0); } while (0)
#define PG8_WAIT_V(n) asm volatile("s_waitcnt vmcnt(" #n ")" ::: "memory")
#define PG8_WAIT_L(n) asm volatile("s_waitcnt lgkmcnt(" #n ")" ::: "memory")
#define PG8_BAR __builtin_amdgcn_s_barrier()
#define PG8_SCHED __builtin_amdgcn_sched_barrier(0)
    Unit cur, nxt; int ui = 0;
    if (!S.next(0, cur)) return;
    f32x4 acc[2][2][4][2];
#pragma unroll
    for (int a = 0; a < 2; ++a)
#pragma unroll
        for (int b = 0; b < 2; ++b)
#pragma unroll
            for (int m = 0; m < 4; ++m)
#pragma unroll
                for (int n = 0; n < 2; ++n) acc[a][b][m][n] = (f32x4){0.f, 0.f, 0.f, 0.f};
    bf16x8 At[4][2], B0[2][2], B1[2][2];
    const char* cA = (const char*)g.A + (size_t)cur.pm * tstep; const char* cB = (const char*)g.Bt + (size_t)cur.pn * tstep;
    S.a_ready(cur);
    if constexpr (SP2) {
        PG8_STAGE(PG8_SB(0, 0), cB, voffB); PG8_STAGE(PG8_SB(0, 1), cB + hstep, voffB); PG8_STAGE(PG8_SA(0, 0), cA, voffA); PG8_STAGE(PG8_SA(0, 1), cA + hstep, voffA);
        if (wr == 1) PG8_BAR;
        PG8_WAIT_V(2); PG8_BAR;
        PG8_STAGE(PG8_SB(1, 0), cB + kstep, voffB); PG8_STAGE(PG8_SA(1, 0), cA + kstep, voffA); PG8_STAGE(PG8_SB(1, 1), cB + hstep + kstep, voffB);
        PG8_WAIT_V(6); PG8_BAR;
    } else {
        PG8_STAGE(PG8_SB(0, 0), cB, voffB); PG8_STAGE(PG8_SA(0, 0), cA, voffA); PG8_STAGE(PG8_SB(0, 1), cB + hstep, voffB); PG8_STAGE(PG8_SA(0, 1), cA + hstep, voffA);
        if (wr == 1) PG8_BAR;
        PG8_WAIT_V(4); PG8_BAR;
        PG8_STAGE(PG8_SB(1, 0), cB + kstep, voffB); PG8_STAGE(PG8_SA(1, 0), cA + kstep, voffA); PG8_STAGE(PG8_SB(1, 1), cB + hstep + kstep, voffB);
        PG8_WAIT_V(6); PG8_BAR;
    }
    for (;;) {
        const bool has_next = S.next(ui + 1, nxt);
        const char* nA = has_next ? (const char*)g.A + (size_t)nxt.pm * tstep : cA; const char* nB = has_next ? (const char*)g.Bt + (size_t)nxt.pn * tstep : cB;
        for (int t = 0; t < nt; t += 2) {
            const bool last = (t == nt - 2);
            const char* a1 = cA + (size_t)(t + 1) * kstep;
            const char* a2 = last ? nA : cA + (size_t)(t + 2) * kstep; const char* b2 = last ? nB : cB + (size_t)(t + 2) * kstep;
            const char* a3 = a2 + kstep; const char* b3 = b2 + kstep;
            if (last && has_next) S.a_ready(nxt);
            if constexpr (SP2) {
            PG8_LDB(B0, 0, 0); PG8_LDB(B1, 0, 1); PG8_SCHED; PG8_LDA(At, 0, 0); PG8_STAGE(PG8_SA(1, 1), a1 + hstep, voffA);
            PG8_WAIT_V(8); PG8_WAIT_L(0); PG8_BAR; PG8_MMA(0, 0, At, B0); PG8_MMA(0, 1, At, B1); PG8_BAR; PG8_SCHED;
            PG8_LDA(At, 0, 1); PG8_STAGE(PG8_SB(0, 0), b2, voffB); PG8_STAGE(PG8_SB(0, 1), b2 + hstep, voffB); PG8_STAGE(PG8_SA(0, 0), a2, voffA);
            PG8_WAIT_V(8); PG8_WAIT_L(0); PG8_BAR; PG8_MMA(1, 0, At, B0); PG8_MMA(1, 1, At, B1); PG8_BAR; PG8_SCHED;
            PG8_LDB(B0, 1, 0); PG8_LDB(B1, 1, 1); PG8_SCHED; PG8_LDA(At, 1, 0); PG8_STAGE(PG8_SA(0, 1), a2 + hstep, voffA);
            PG8_WAIT_V(8); PG8_WAIT_L(0); PG8_BAR; PG8_MMA(0, 0, At, B0); PG8_MMA(0, 1, At, B1); PG8_BAR; PG8_SCHED;
            PG8_LDA(At, 1, 1); PG8_STAGE(PG8_SB(1, 0), b3, voffB); PG8_STAGE(PG8_SB(1, 1), b3 + hstep, voffB); PG8_STAGE(PG8_SA(1, 0), a3, voffA);
            PG8_WAIT_V(8); PG8_WAIT_L(0); PG8_BAR; PG8_MMA(1, 0, At, B0); PG8_MMA(1, 1, At, B1); PG8_BAR; PG8_SCHED;
            } else {
            PG8_LDB(B0, 0, 0); PG8_SCHED; PG8_LDA(At, 0, 0); PG8_STAGE(PG8_SA(1, 1), a1 + hstep, voffA);
            PG8_WAIT_L(8); PG8_BAR; PG8_WAIT_L(0); PG8_MMA(0, 0, At, B0); PG8_BAR; PG8_SCHED;
            PG8_LDB(B1, 0, 1); PG8_STAGE(PG8_SB(0, 0), b2, voffB);
            PG8_BAR; PG8_WAIT_L(0); PG8_MMA(0, 1, At, B1); PG8_BAR;
            PG8_LDA(At, 0, 1); PG8_STAGE(PG8_SA(0, 0), a2, voffA);
            PG8_BAR; PG8_WAIT_L(0); PG8_MMA(1, 0, At, B0); PG8_BAR; PG8_SCHED;
            PG8_STAGE(PG8_SB(0, 1), b2 + hstep, voffB);
            PG8_WAIT_V(6); PG8_BAR; PG8_MMA(1, 1, At, B1); PG8_BAR;
            PG8_LDB(B0, 1, 0); PG8_SCHED; PG8_LDA(At, 1, 0); PG8_STAGE(PG8_SA(0, 1), a2 + hstep, voffA);
            PG8_WAIT_L(8); PG8_BAR; PG8_WAIT_L(0); PG8_MMA(0, 0, At, B0); PG8_BAR; PG8_SCHED;
            PG8_LDB(B1, 1, 1); PG8_STAGE(PG8_SB(1, 0), b3, voffB);
            PG8_BAR; PG8_WAIT_L(0); PG8_MMA(0, 1, At, B1); PG8_BAR;
            PG8_LDA(At, 1, 1); PG8_STAGE(PG8_SA(1, 0), a3, voffA);
            PG8_BAR; PG8_WAIT_L(0); PG8_MMA(1, 0, At, B0); PG8_BAR; PG8_SCHED;
            PG8_STAGE(PG8_SB(1, 1), b3 + hstep, voffB);
            PG8_WAIT_V(6); PG8_BAR; PG8_MMA(1, 1, At, B1); PG8_BAR;
            }
        }
        if constexpr (ALIGN_EPI) { if (wr == 0) PG8_BAR; }
        if constexpr (!Epi::AFTER_DRAIN) { E(acc, cur, wr, wc, fr, fq); S.done(cur); }
        if (!has_next) break;
#pragma unroll
        for (int a = 0; a < 2; ++a)
#pragma unroll
            for (int b = 0; b < 2; ++b)
#pragma unroll
                for (int m = 0; m < 4; ++m)
#pragma unroll
                    for (int n = 0; n < 2; ++n) acc[a][b][m][n] = (f32x4){0.f, 0.f, 0.f, 0.f};
        cur = nxt; cA = nA; cB = nB; ++ui;
        if constexpr (ALIGN_EPI) { if (wr == 1) PG8_BAR; }
    }
    PG8_WAIT_V(0);
    if constexpr (!ALIGN_EPI) { if (wr == 0) PG8_BAR; }
    PG8_BAR;
    if constexpr (Epi::AFTER_DRAIN) { E.fused(acc, cur, wr, wc, fr, fq, lds, wid, lane); S.done(cur); }
#undef PG8_SA
#undef PG8_SB
#undef PG8_STAGE
#undef PG8_LDA
#undef PG8_LDB
#undef PG8_MMA
#undef PG8_WAIT_V
#undef PG8_WAIT_L
#undef PG8_BAR
#undef PG8_SCHED
}
}
typedef unsigned short bf16_t;
typedef float f32x4 __attribute__((ext_vector_type(4)));
constexpr int NB = 4, SEQ = 8192, CTXL = 256;
constexpr int NX = NB * SEQ, NC = NB * CTXL, NT = NX + NC;
constexpr int DFF = 2816;
constexpr size_t MiB = 1u << 20;
constexpr size_t WS_WIN = 0, WS_WOUT = 8 * MiB, WS_WGU = 10 * MiB, WS_WDN = 21 * MiB, WS_SMALL = 461 * MiB, WS_END = 470 * MiB, WS_H = 32 * MiB, WS_ZQK = 98 * MiB, WS_ZR = 164 * MiB,
                 WS_GQK = 329 * MiB, WS_SST = 395 * MiB, WS_ACT = 98 * MiB;
constexpr size_t SM_MOD = 0, SM_MGATE = 128 * 1024, SM_MCHUNK = 4608 * 1024, SM_NST = 4736 * 1024, SM_MSTATE = 5888 * 1024, SM_GBT = 6016 * 1024, SM_BAR = 7424 * 1024;
constexpr size_t OUT_QK = 0, OUT_GATES = (size_t)NT * 1024 * 2;
constexpr int PITCH = 136, IMG_BYTES = 128 * PITCH * 2;
constexpr int LDS_BYTES = 151552, SMALL_OFF = 4 * IMG_BYTES;
constexpr float EPSN = 1e-6f;
#ifndef P5SEL
#define P5SEL 0
#endif

struct Params {
    const float *x, *c, *ctx, *c_ctx, *w_ada, *b_ada, *g_mix, *w_in, *conv_w, *m_gate_b, *m_norm_g, *g_gate_w, *g_gate_b, *g_norm_g, *w_out, *g_ffn, *w_gu, *w_down, *g_final;
    float* out; unsigned char* ws;
};

#define DI __device__ __forceinline__
#define LAS __attribute__((address_space(3)))
#define XB_TMO      128
#define XB_XCNT(j)  (256  + 64 * (j))
#define XB_XSUB(j)  (1280 + 64 * (j))
#define XB_XGEN(j)  (2304 + 64 * (j))
#define XB_TOP      3328
#define XB_TOPGEN   3392
#define XCD_BAR_WORDS 3456
#define XB_SPIN_CAP (1u << 18)

__device__ __forceinline__ unsigned xb_ld(unsigned* p)              { return __hip_atomic_load(p, __ATOMIC_RELAXED, __HIP_MEMORY_SCOPE_AGENT); }
__device__ __forceinline__ unsigned xb_add(unsigned* p, unsigned v) { return __hip_atomic_fetch_add(p, v, __ATOMIC_RELAXED, __HIP_MEMORY_SCOPE_AGENT); }
__device__ __forceinline__ unsigned xb_xcc_id() { return (unsigned)__builtin_amdgcn_s_getreg((3 << 11) | 20) & 0xFu; }
#define XB_SPIN(cond, bar) do { unsigned _sp = 0; while (cond) { __builtin_amdgcn_s_sleep(1); \
    if ((++_sp & 255u) == 0u) { if (xb_ld(&(bar)[XB_TMO])) break; if (_sp > XB_SPIN_CAP) { atomicAdd(&(bar)[XB_TMO], 1u); break; } } } } while (0)

struct XcdBarrier {
    unsigned* bar; unsigned x;
    volatile LAS unsigned* st;
};

__device__ __forceinline__ XcdBarrier xcd_barrier_post(unsigned* bar, volatile LAS unsigned* st) {
    XcdBarrier b; b.bar = bar; b.x = xb_xcc_id(); b.st = st;
    if (threadIdx.x == 0) (void)xb_add(&bar[XB_XCNT(b.x)], 1u);
    return b;
}
__device__ __forceinline__ void xcd_barrier_complete(unsigned* bar, unsigned x, unsigned& nloc, unsigned& nx) {
    const unsigned G = gridDim.x * gridDim.y * gridDim.z;
    unsigned sum, cnt, mine, sp = 0u;
    for (;;) {
        sum = 0u; cnt = 0u; mine = 0u;
#pragma unroll
        for (unsigned j = 0; j < 16; ++j) { const unsigned c = xb_ld(&bar[XB_XCNT(j)]); sum += c; cnt += (c > 0u) ? 1u : 0u; mine = (j == x) ? c : mine; }
        if (sum == G) break;
        __builtin_amdgcn_s_sleep(1);
        if ((++sp & 255u) == 0u) { if (xb_ld(&bar[XB_TMO])) break; if (sp > XB_SPIN_CAP) { atomicAdd(&bar[XB_TMO], 1u); break; } }
    }
    nloc = mine > 0u ? mine : 1u; nx = cnt > 0u ? cnt : 1u;
}

__device__ __forceinline__ void xcd_barrier(const XcdBarrier& b) {
    asm volatile("s_waitcnt vmcnt(0)" ::: "memory");
    __syncthreads();
    if (threadIdx.x == 0) {
        unsigned* bar = b.bar;
        __builtin_amdgcn_s_waitcnt(0);
        unsigned nloc = b.st[0], nx = b.st[1];
        if (nloc == 0u) { xcd_barrier_complete(bar, b.x, nloc, nx); b.st[0] = nloc; b.st[1] = nx; }
        const unsigned old = xb_add(&bar[XB_XSUB(b.x)], 1u);
        const unsigned gen = old / nloc;
        if (old + 1u == (gen + 1u) * nloc) {
            __builtin_amdgcn_fence(__ATOMIC_RELEASE, "agent");
            asm volatile("s_waitcnt vmcnt(0)" ::: "memory");
            const unsigned og = xb_add(&bar[XB_TOP], 1u);
            const unsigned tg = og / nx;
            if (og + 1u == (tg + 1u) * nx) xb_add(&bar[XB_TOPGEN], 1u);
            else XB_SPIN(xb_ld(&bar[XB_TOPGEN]) == tg, bar);
            __builtin_amdgcn_fence(__ATOMIC_ACQUIRE, "agent");
            xb_add(&bar[XB_XGEN(b.x)], 1u);
            asm volatile("s_waitcnt vmcnt(0)" ::: "memory");
        } else {
            XB_SPIN(xb_ld(&bar[XB_XGEN(b.x)]) == gen, bar);
            __builtin_amdgcn_fence(__ATOMIC_ACQUIRE, "agent");
            asm volatile("s_waitcnt vmcnt(0)" ::: "memory");
        }
    }
    __syncthreads();
}

DI float bf2f(bf16_t v) { return __uint_as_float((unsigned)v << 16); }
DI unsigned f2bfu(float f) { unsigned u = __float_as_uint(f); return (u + 0x7fffu + ((u >> 16) & 1u)) >> 16; }
DI bf16_t f2bf(float f) { return __builtin_bit_cast(bf16_t, (__bf16)f); }
typedef __bf16 bf16x2_t __attribute__((ext_vector_type(2)));
DI unsigned pk2(float lo, float hi) { const bf16x2_t v = {(__bf16)lo, (__bf16)hi}; return __builtin_bit_cast(unsigned, v); }
DI void unpack8(const uint4 r, float (&o)[8]) {
    o[0] = __uint_as_float(r.x << 16); o[1] = __uint_as_float(r.x & 0xffff0000u); o[2] = __uint_as_float(r.y << 16); o[3] = __uint_as_float(r.y & 0xffff0000u);
    o[4] = __uint_as_float(r.z << 16); o[5] = __uint_as_float(r.z & 0xffff0000u); o[6] = __uint_as_float(r.w << 16); o[7] = __uint_as_float(r.w & 0xffff0000u); }
DI uint4 pack8(const float (&o)[8]) { uint4 r; r.x = pk2(o[0], o[1]); r.y = pk2(o[2], o[3]); r.z = pk2(o[4], o[5]); r.w = pk2(o[6], o[7]); return r; }
DI void lds_barrier() { asm volatile("s_waitcnt lgkmcnt(0)" ::: "memory"); __builtin_amdgcn_s_barrier(); asm volatile("" ::: "memory"); }
DI float wave_sum(float v) {
#pragma unroll
    for (int o = 1; o < 64; o <<= 1) v += __shfl_xor(v, o);
    return v; }
DI float wave_max(float v) {
#pragma unroll
    for (int o = 1; o < 64; o <<= 1) v = fmaxf(v, __shfl_xor(v, o));
    return v; }
DI float logsig(float x) { return fminf(x, 0.f) - log1pf(expf(-fabsf(x))); }
DI float sigm(float x) { return __builtin_amdgcn_rcpf(1.0f + __expf(-x)); }
DI float logsig_fast(float x) { return fminf(x, 0.f) - __logf(1.0f + __expf(-fabsf(x))); }

typedef short bf16x8 __attribute__((ext_vector_type(8)));
typedef short s16x4 __attribute__((ext_vector_type(4)));
typedef short v4i16_t __attribute__((ext_vector_type(4)));
typedef float f32x16 __attribute__((ext_vector_type(16)));
#define LAS3 __attribute__((address_space(3)))
struct Own {
    int rbase, cbase;
    static constexpr int NRS = 16;
    DI int row(int idx) const { return rbase + (idx & 3) + 8 * ((idx & 15) >> 2); }
    DI int col(int idx) const { return cbase + 32 * (idx >> 4); }
    static DI int rslot(int idx) { return idx & 15; }
    DI int slotrow(int rs) const { return rbase + (rs & 3) + 8 * (rs >> 2); }
};
DI Own make_own(int tid) { Own o; const int w = tid >> 6, lane = tid & 63; o.rbase = 32 * (w & 3) + 4 * (lane >> 5); o.cbase = 64 * (w >> 2) + (lane & 31); return o; }
DI s16x4 trrd(const bf16_t* p) { return __builtin_bit_cast(s16x4, __builtin_amdgcn_ds_read_tr16_b64_v4i16((LAS3 v4i16_t*)p)); }
template <bool ATR, bool BTR, int NKS = 8> DI void mm128(float (&acc)[32], const bf16_t* A, const bf16_t* B, int tid, int ks0 = 0) {
    const int w = tid >> 6, lane = tid & 63, tr = w & 3, tc0 = 2 * (w >> 2), h = lane >> 5, l31 = lane & 31, blk = (lane >> 4) & 1, q = (lane & 15) >> 2, pq = lane & 3;
    f32x16 c0, c1;
#pragma unroll
    for (int i = 0; i < 16; ++i) { c0[i] = acc[i]; c1[i] = acc[16 + i]; }
    const bf16_t* ap = (ATR ? A + (8 * h + q) * PITCH + 32 * tr + 16 * blk + 4 * pq : A + (32 * tr + l31) * PITCH + 8 * h) + (ATR ? ks0 * 16 * PITCH : ks0 * 16);
    const bf16_t* bp = (BTR ? B + (8 * h + q) * PITCH + 32 * tc0 + 16 * blk + 4 * pq : B + (32 * tc0 + l31) * PITCH + 8 * h) + (BTR ? ks0 * 16 * PITCH : ks0 * 16);
#pragma unroll
    for (int ks = 0; ks < NKS; ++ks) {
        bf16x8 a, b0, b1;
        if (ATR) { const s16x4 lo = trrd(ap + ks * 16 * PITCH), hi = trrd(ap + (ks * 16 + 4) * PITCH); a = __builtin_shufflevector(lo, hi, 0, 1, 2, 3, 4, 5, 6, 7); }
        else a = *(const LAS3 bf16x8*)(ap + ks * 16);
        if (BTR) { const s16x4 lo0 = trrd(bp + ks * 16 * PITCH), hi0 = trrd(bp + (ks * 16 + 4) * PITCH), lo1 = trrd(bp + ks * 16 * PITCH + 32), hi1 = trrd(bp + (ks * 16 + 4) * PITCH + 32);
            b0 = __builtin_shufflevector(lo0, hi0, 0, 1, 2, 3, 4, 5, 6, 7); b1 = __builtin_shufflevector(lo1, hi1, 0, 1, 2, 3, 4, 5, 6, 7); }
        else { b0 = *(const LAS3 bf16x8*)(bp + ks * 16); b1 = *(const LAS3 bf16x8*)(bp + 32 * PITCH + ks * 16); }
        c0 = __builtin_amdgcn_mfma_f32_32x32x16_bf16(a, b0, c0, 0, 0, 0);
        c1 = __builtin_amdgcn_mfma_f32_32x32x16_bf16(a, b1, c1, 0, 0, 0);
    }
#pragma unroll
    for (int i = 0; i < 16; ++i) { acc[i] = c0[i]; acc[16 + i] = c1[i]; }
}
DI void zero32(float (&a)[32]) {
#pragma unroll
    for (int i = 0; i < 32; ++i) a[i] = 0.f; }
DI void load_img(bf16_t* img, const bf16_t* g, size_t gp, int tid) {
#pragma unroll
    for (int i = 0; i < 4; ++i) { const int id = tid + 512 * i, r = id >> 4, c8 = (id & 15) * 8; *(uint4*)(img + r * PITCH + c8) = *(const uint4*)(g + (size_t)r * gp + c8); }
}

DI int chperm(int ch) { return (ch & 10) | ((ch & 1) << 2) | ((ch >> 2) & 1); }
DI void load_img_sw(bf16_t* img, const bf16_t* g, size_t gp, int tid) {
#pragma unroll
    for (int i = 0; i < 4; ++i) { const int id = tid + 512 * i, r = id >> 4, ch = id & 15; *(uint4*)(img + r * PITCH + chperm(ch) * 8) = *(const uint4*)(g + (size_t)r * gp + ch * 8); }
}
DI int src_in(int n) { return n < 2048 ? n : (n < 3584 ? n + 16 : (n < 3600 ? n - 1536 : (n < 3632 ? n : -1))); }
DI int src_gu(int n) { const int pn = n >> 8, bj = (n >> 7) & 1, j = n & 127; return bj * 2816 + pn * 128 + j; }
template <int MAP> DI void transpose_item(const float* W, int Nsrc, int K, bf16_t* WT, int ndest, float* scr, int item, int lane) {
    const int nblk = ndest / 32, kb = item / nblk, nb = item % nblk, k0 = 64 * kb, n0 = 32 * nb;
    const int nn = n0 + (lane & 31); const int sc = MAP == 0 ? nn : (MAP == 1 ? src_in(nn) : src_gu(nn));
#pragma unroll 8
    for (int i = 0; i < 32; ++i) { const int kk = 2 * i + (lane >> 5); scr[kk * 33 + (lane & 31)] = sc >= 0 ? W[(size_t)(k0 + kk) * Nsrc + sc] : 0.f; }
    asm volatile("s_waitcnt lgkmcnt(0)" ::: "memory");
    const int c = lane & 7;
#pragma unroll
    for (int j = 0; j < 4; ++j) { const int n = (lane >> 3) + 8 * j; const float* s = scr + (8 * c) * 33 + n;
        uint4 o; o.x = pk2(s[0 * 33], s[1 * 33]); o.y = pk2(s[2 * 33], s[3 * 33]); o.z = pk2(s[4 * 33], s[5 * 33]); o.w = pk2(s[6 * 33], s[7 * 33]);
        *(uint4*)(WT + (size_t)(n0 + n) * K + k0 + 8 * c) = o; }
    asm volatile("s_waitcnt lgkmcnt(0)" ::: "memory");
}
DI void norm_rows(const float* xsrc, const float* ctxsrc, bf16_t* dst, int nrows, const float* g, const float* mod, int sh_off, int sc_off, int gw, int ngw, int lane) {
    for (int row = gw; row < nrows; row += ngw) {
        const float* src; const float* mrow;
        if (row < NX) { src = xsrc + (size_t)row * 1024; mrow = mod + (row >> 13) * 6144; } else { src = ctxsrc + (size_t)(row - NX) * 1024; mrow = mod + 4 * 6144; }
        f32x4 v[4]; float ss = 0.f;
#pragma unroll
        for (int j = 0; j < 4; ++j) { v[j] = __builtin_nontemporal_load((const f32x4*)(src + 512 * (j >> 1) + 8 * lane + 4 * (j & 1))); ss += (v[j].x * v[j].x + v[j].y * v[j].y) + (v[j].z * v[j].z + v[j].w * v[j].w); }
        const float rs = rsqrtf(wave_sum(ss) * (1.0f / 1024.0f) + EPSN);
#pragma unroll
        for (int hh = 0; hh < 2; ++hh) { const int col = 512 * hh + 8 * lane; float o[8];
#pragma unroll
            for (int e4 = 0; e4 < 2; ++e4) { const f32x4 gg = *(const f32x4*)(g + col + 4 * e4), sc = *(const f32x4*)(mrow + sc_off + col + 4 * e4), sh = *(const f32x4*)(mrow + sh_off + col + 4 * e4);
                const f32x4 r = v[2 * hh + e4] * rs * gg * (sc + 1.0f) + sh; o[4 * e4] = r.x; o[4 * e4 + 1] = r.y; o[4 * e4 + 2] = r.z; o[4 * e4 + 3] = r.w; }
            *(uint4*)(dst + (size_t)row * 1024 + col) = pack8(o); }
    }
}
DI void norm_rows_b(const bf16_t* srcb, bf16_t* dst16, float* dst32, int nrows, const float* g, const float* mod, int sh_off, int sc_off, int gw, int ngw, int lane) {
    for (int row0 = gw; row0 < nrows; row0 += 2 * ngw) {
        const int row1 = row0 + ngw; const bool has1 = row1 < nrows; const int r1 = has1 ? row1 : row0;
        uint4 a0 = *(const uint4*)(srcb + (size_t)row0 * 1024 + 8 * lane), a1 = *(const uint4*)(srcb + (size_t)row0 * 1024 + 512 + 8 * lane);
        uint4 b0 = *(const uint4*)(srcb + (size_t)r1 * 1024 + 8 * lane), b1 = *(const uint4*)(srcb + (size_t)r1 * 1024 + 512 + 8 * lane);
#pragma unroll
        for (int q = 0; q < 2; ++q) {
            if (q == 1 && !has1) break;
            const int row = q ? row1 : row0; const float* mrow = mod + (row >> 13) * 6144;
            float v[16]; { float t8[8]; unpack8(q ? b0 : a0, t8);
#pragma unroll
                for (int e = 0; e < 8; ++e) v[e] = t8[e];
                unpack8(q ? b1 : a1, t8);
#pragma unroll
                for (int e = 0; e < 8; ++e) v[8 + e] = t8[e]; }
            float ss = 0.f;
#pragma unroll
            for (int e = 0; e < 16; ++e) ss += v[e] * v[e];
            const float rs = rsqrtf(wave_sum(ss) * (1.0f / 1024.0f) + EPSN);
#pragma unroll
            for (int hh = 0; hh < 2; ++hh) { const int col = 512 * hh + 8 * lane; float o[8];
#pragma unroll
                for (int e4 = 0; e4 < 2; ++e4) { const f32x4 gg = *(const f32x4*)(g + col + 4 * e4);
                    if (dst16) { const f32x4 sc = *(const f32x4*)(mrow + sc_off + col + 4 * e4), sh = *(const f32x4*)(mrow + sh_off + col + 4 * e4);
                        o[4 * e4] = v[8 * hh + 4 * e4] * rs * gg.x * (sc.x + 1.0f) + sh.x; o[4 * e4 + 1] = v[8 * hh + 4 * e4 + 1] * rs * gg.y * (sc.y + 1.0f) + sh.y;
                        o[4 * e4 + 2] = v[8 * hh + 4 * e4 + 2] * rs * gg.z * (sc.z + 1.0f) + sh.z; o[4 * e4 + 3] = v[8 * hh + 4 * e4 + 3] * rs * gg.w * (sc.w + 1.0f) + sh.w; }
                    else { o[4 * e4] = v[8 * hh + 4 * e4] * rs * gg.x; o[4 * e4 + 1] = v[8 * hh + 4 * e4 + 1] * rs * gg.y; o[4 * e4 + 2] = v[8 * hh + 4 * e4 + 2] * rs * gg.z; o[4 * e4 + 3] = v[8 * hh + 4 * e4 + 3] * rs * gg.w; } }
                if (dst16) *(uint4*)(dst16 + (size_t)row * 1024 + col) = pack8(o);
                else { __builtin_nontemporal_store((f32x4){o[0], o[1], o[2], o[3]}, (f32x4*)(dst32 + (size_t)row * 1024 + col)); __builtin_nontemporal_store((f32x4){o[4], o[5], o[6], o[7]}, (f32x4*)(dst32 + (size_t)row * 1024 + col + 4)); } }
        }
    }
}
__global__ void __launch_bounds__(512, 2) mega_fwd(Params p) {
    extern __shared__ __attribute__((aligned(16))) unsigned char lds[];
    cg::grid_group grid = cg::this_grid();
    const int tid = threadIdx.x, lane = tid & 63, wave = __builtin_amdgcn_readfirstlane(tid >> 6);
    const int bid = blockIdx.x, G = gridDim.x;
    const int gw = bid * 8 + wave, ngw = G * 8;
    unsigned char* ws = p.ws;
    bf16_t* Wt_in = (bf16_t*)(ws + WS_WIN); bf16_t* Wt_out = (bf16_t*)(ws + WS_WOUT); bf16_t* Wt_gu = (bf16_t*)(ws + WS_WGU); bf16_t* Wt_dn = (bf16_t*)(ws + WS_WDN);
    float* mod = (float*)(ws + WS_SMALL + SM_MOD); float* mgate = (float*)(ws + WS_SMALL + SM_MGATE); float* mchunk = (float*)(ws + WS_SMALL + SM_MCHUNK);
    bf16_t* xres = (bf16_t*)(ws + WS_GQK);
    float* nst = (float*)(ws + WS_SMALL + SM_NST); float* mstate = (float*)(ws + WS_SMALL + SM_MSTATE); float* gbt = (float*)(ws + WS_SMALL + SM_GBT);
    bf16_t* hbuf = (bf16_t*)(ws + WS_H); bf16_t* mix = hbuf;
    bf16_t* zqk = (bf16_t*)(ws + WS_ZQK); bf16_t* Cst = zqk; bf16_t* zr = (bf16_t*)(ws + WS_ZR); bf16_t* gqk = (bf16_t*)(ws + WS_GQK); bf16_t* Sst = (bf16_t*)(ws + WS_SST);
    bf16_t* act = (bf16_t*)(ws + WS_ACT);
    bf16_t* qk = (bf16_t*)((unsigned char*)p.out + OUT_QK); float* gates = (float*)((unsigned char*)p.out + OUT_GATES);
    bf16_t* R1 = (bf16_t*)(lds); bf16_t* R2 = (bf16_t*)(lds + IMG_BYTES); bf16_t* R3 = (bf16_t*)(lds + 2 * IMG_BYTES); bf16_t* R4 = (bf16_t*)(lds + 3 * IMG_BYTES);
    float* smf = (float*)(lds + SMALL_OFF); float* Himg = (float*)lds;

    unsigned* barw = (unsigned*)(ws + WS_SMALL + SM_BAR); unsigned* modctr = (unsigned*)(ws + WS_SMALL + SM_BAR + 16384 + 128);
    if (G == 0x7fffffff) grid.sync();
    if (tid < 4) ((volatile LAS unsigned*)(lds + LDS_BYTES - 16))[tid] = 0u;
    __syncthreads();
    XcdBarrier bar = xcd_barrier_post(barw, (volatile LAS unsigned*)(lds + LDS_BYTES - 16));
    { int tid = threadIdx.x; asm volatile("" : "+v"(tid)); const int lane = tid & 63, wave = __builtin_amdgcn_readfirstlane(tid >> 6), gw = bid * 8 + wave; (void)lane; (void)gw;
    {
        float* scs = (float*)lds;
        float* red = (float*)(lds + 20480);
        for (int i = tid; i < 5120; i += 512) { const int v = i >> 10, k = i & 1023; const float val = v < 4 ? p.c[v * 1024 + k] : p.c_ctx[k]; scs[i] = val * sigm(val); }
        __syncthreads();
        for (int item = bid; item < 192; item += G) {
            const int col = item * 32 + (lane & 31), kh = lane >> 5;
            float a[5] = {0.f, 0.f, 0.f, 0.f, 0.f};
#pragma unroll 8
            for (int i = 0; i < 64; ++i) { const int k = wave * 128 + 2 * i + kh; const float w = p.w_ada[(size_t)k * 6144 + col];
#pragma unroll
                for (int v = 0; v < 5; ++v) a[v] += scs[v * 1024 + k] * w; }
#pragma unroll
            for (int v = 0; v < 5; ++v) a[v] += __shfl_xor(a[v], 32);
            if (lane < 32) {
#pragma unroll
                for (int v = 0; v < 5; ++v) red[(wave * 5 + v) * 32 + lane] = a[v]; }
            __syncthreads();
            if (tid < 160) { const int v = tid >> 5, cc = tid & 31; float s = 0.f;
#pragma unroll
                for (int w = 0; w < 8; ++w) s += red[(w * 5 + v) * 32 + cc];
                __hip_atomic_store(mod + v * 6144 + item * 32 + cc, s + p.b_ada[item * 32 + cc], __ATOMIC_RELAXED, __HIP_MEMORY_SCOPE_AGENT); }
            asm volatile("s_waitcnt vmcnt(0)" ::: "memory");
            __syncthreads();
            if (tid == 0) __hip_atomic_fetch_add(modctr, 1u, __ATOMIC_RELAXED, __HIP_MEMORY_SCOPE_AGENT);
        }
        float* scr = (float*)(lds + 32768 + wave * 8448);
        constexpr int I_IN = 16 * 120, I_OUT = 16 * 32, I_GU = 16 * 176, I_DN = 44 * 32;
        for (int it = gw; it < I_IN + I_OUT + I_GU + I_DN; it += ngw) {
            int r = it;
            if (r < I_IN) { transpose_item<1>(p.w_in, 3632, 1024, Wt_in, 3840, scr, r, lane); continue; } r -= I_IN;
            if (r < I_OUT) { transpose_item<0>(p.w_out, 1024, 1024, Wt_out, 1024, scr, r, lane); continue; } r -= I_OUT;
            if (r < I_GU) { transpose_item<2>(p.w_gu, 5632, 1024, Wt_gu, 5632, scr, r, lane); continue; } r -= I_GU;
            transpose_item<0>(p.w_down, 1024, 2816, Wt_dn, 1024, scr, r, lane);
        }
    }
    }
    { int tid = threadIdx.x; asm volatile("" : "+v"(tid)); const int lane = tid & 63, wave = __builtin_amdgcn_readfirstlane(tid >> 6), gw = bid * 8 + wave; (void)lane; (void)gw;
    if (tid == 0) { unsigned sp = 0; while (__hip_atomic_load(modctr, __ATOMIC_RELAXED, __HIP_MEMORY_SCOPE_AGENT) < 192u && ++sp < (1u << 22)) __builtin_amdgcn_s_sleep(2);
        __builtin_amdgcn_fence(__ATOMIC_ACQUIRE, "agent"); asm volatile("s_waitcnt vmcnt(0)" ::: "memory"); }
    __syncthreads();
    norm_rows(p.x, p.ctx, hbuf, NT, p.g_mix, mod, 0, 1024, gw, ngw, lane);
    }
    xcd_barrier(bar);
    {
        pg8::Gemm g{hbuf, Wt_in, NT, 3840, 1024}; pg8::StaticOrder S; S.init(NT, 3840, G, bid);
        pg8::EpiZ E{zqk, zr, gates};
        pg8::gemm_phase<pg8::EpiZ, pg8::StaticOrder, true, true>((PG8_LAS unsigned char*)lds, g, S, E);
    }
    xcd_barrier(bar);
    { int tid = threadIdx.x; asm volatile("" : "+v"(tid)); const int lane = tid & 63, wave = __builtin_amdgcn_readfirstlane(tid >> 6), gw = bid * 8 + wave; (void)lane; (void)gw;
    {
        auto conv_item = [&](const bool isx, const int b, const int r, const int seg) {
            const size_t T0 = isx ? (size_t)b * 8192 + r * 64 : (size_t)NX + b * 256 + seg * 64;
            const int ch0 = (tid & 127) * 8, c0 = (tid >> 7) * 16;
            const float oscale = ch0 >= 512 ? 0.08838834764831845f : 1.0f;
            const LAS float* wl = (const LAS float*)(lds + 81920) + ch0;
            const bool rv0 = isx ? (r > 0) : false, rv2 = isx ? (r < 127) : false;
            const bf16_t* l0 = zqk + ((isx ? (size_t)b * 8192 + (size_t)max(r - 1, 0) * 64 : T0)) * 1024 + ch0;
            const bf16_t* l1 = zqk + T0 * 1024 + ch0;
            const bf16_t* l2 = zqk + ((isx ? (size_t)b * 8192 + (size_t)min(r + 1, 127) * 64 : T0)) * 1024 + ch0;
            const int clo = isx ? 0 : -seg * 64, chi = isx ? 63 : 255 - seg * 64;
            uint4 ring[6][3];
#define CONV_LOAD(j) { const int cc_ = min(max(c0 - 1 + (j), clo), chi); ring[(j) % 6][0] = *(const uint4*)(l0 + (ptrdiff_t)cc_ * 1024); ring[(j) % 6][1] = *(const uint4*)(l1 + (ptrdiff_t)cc_ * 1024); ring[(j) % 6][2] = *(const uint4*)(l2 + (ptrdiff_t)cc_ * 1024); }
            CONV_LOAD(0) CONV_LOAD(1) CONV_LOAD(2) CONV_LOAD(3) CONV_LOAD(4)
#pragma unroll
            for (int k = 0; k < 16; ++k) {
                if (k + 5 <= 17) CONV_LOAD(k + 5)
                const int c = c0 + k;
                float acc[8] = {0.f, 0.f, 0.f, 0.f, 0.f, 0.f, 0.f, 0.f};
                const LAS float* wl2 = wl; asm volatile("" : "+v"(wl2));
#pragma unroll
                for (int di = 0; di < 3; ++di) {
                    const bool rv = di == 0 ? rv0 : (di == 2 ? rv2 : true);
                    if (rv) {
#pragma unroll
                        for (int dj = 0; dj < 3; ++dj) {
                            const int cc = c + dj - 1;
                            if (cc >= clo && cc <= chi) {
                                float v[8]; unpack8(ring[(k + dj) % 6][di], v);
                                const f32x4 w0 = *(const LAS f32x4*)(wl2 + (di * 3 + dj) * 1024), w1 = *(const LAS f32x4*)(wl2 + (di * 3 + dj) * 1024 + 4);
                                acc[0] += w0.x * v[0]; acc[1] += w0.y * v[1]; acc[2] += w0.z * v[2]; acc[3] += w0.w * v[3];
                                acc[4] += w1.x * v[4]; acc[5] += w1.y * v[5]; acc[6] += w1.z * v[6]; acc[7] += w1.w * v[7];
                            }
                        }
                    }
                }
#pragma unroll
                for (int e = 0; e < 8; ++e) acc[e] = acc[e] * sigm(acc[e]) * oscale;
                *(uint4*)(qk + (T0 + c) * 1024 + ch0) = pack8(acc);
            }
#undef CONV_LOAD
        };
        auto gprep_item = [&](const int gc) {
            const size_t T0 = (size_t)gc * 64;
            float* glr_s = (float*)lds;
            bf16_t* gq_s = (bf16_t*)(lds + 8192);
            bf16_t* gk_s = (bf16_t*)(lds + 8192 + 32768);
            __syncthreads();
            { const int t = tid >> 3, c4 = (tid & 7) * 4; *(f32x4*)(glr_s + t * 32 + c4) = *(const f32x4*)(gates + (T0 + t) * 64 + 16 + c4); }
#pragma unroll
            for (int i = 0; i < 4; ++i) { const int id = tid + 512 * i, t = id >> 5, c8 = (id & 31) * 8;
                *(uint4*)(gq_s + t * 256 + c8) = *(const uint4*)(zr + (T0 + t) * 2560 + 1024 + c8);
                *(uint4*)(gk_s + t * 256 + c8) = *(const uint4*)(zr + (T0 + t) * 2560 + 1280 + c8); }
            __syncthreads();
            const int dir = tid >> 8, ch = tid & 255;
            f32x4 W[4];
#pragma unroll
            for (int r = 0; r < 4; ++r) { W[r].x = p.g_gate_w[(dir * 16 + 4 * r) * 256 + ch]; W[r].y = p.g_gate_w[(dir * 16 + 4 * r + 1) * 256 + ch]; W[r].z = p.g_gate_w[(dir * 16 + 4 * r + 2) * 256 + ch]; W[r].w = p.g_gate_w[(dir * 16 + 4 * r + 3) * 256 + ch]; }
            const float bias = p.g_gate_b[dir * 256 + ch];
            bf16_t* qo = gqk + (size_t)(dir * 2 + 0) * NT * 256; bf16_t* ko = gqk + (size_t)(dir * 2 + 1) * NT * 256;
            float cum = 0.f;
#pragma unroll 1
            for (int c16 = 0; c16 < 64; c16 += 16) {
                float la[16];
#pragma unroll
                for (int q = 0; q < 16; ++q) {
                    const int pp = c16 + q, t = dir ? 63 - pp : pp;
                    const f32x4* g4 = (const f32x4*)(glr_s + t * 32 + dir * 16);
                    const f32x4 g0 = g4[0], g1 = g4[1], g2 = g4[2], g3 = g4[3];
                    const float x0 = g0.x * W[0].x + g0.y * W[0].y + g0.z * W[0].z + g0.w * W[0].w, x1 = g1.x * W[1].x + g1.y * W[1].y + g1.z * W[1].z + g1.w * W[1].w;
                    const float x2 = g2.x * W[2].x + g2.y * W[2].y + g2.z * W[2].z + g2.w * W[2].w, x3 = g3.x * W[3].x + g3.y * W[3].y + g3.z * W[3].z + g3.w * W[3].w;
                    la[q] = logsig_fast(bias + ((x0 + x1) + (x2 + x3))) * 0.0625f;
                }
#pragma unroll
                for (int q = 0; q < 16; ++q) {
                    const int pp = c16 + q, t = dir ? 63 - pp : pp;
                    cum += la[q];
                    qo[(T0 + t) * 256 + ch] = f2bf(bf2f(gq_s[t * 256 + ch]) * 0.125f * __expf(cum));
                    ko[(T0 + t) * 256 + ch] = f2bf(bf2f(gk_s[t * 256 + ch]) * __expf(-cum));
                }
            }
            gbt[((size_t)dir * 528 + gc) * 256 + ch] = cum;
        };
        auto mprep_item = [&](const int ck) {
            const size_t T0 = ck < 256 ? (size_t)ck * 128 : (size_t)NX + (size_t)(ck - 256) * 128;
            const int dir = wave >> 2, h = wave & 3, icol = dir * 8 + h, fcol = dir * 8 + 4 + h;
            const int p0 = 2 * lane, p1 = 2 * lane + 1, t0 = dir ? 127 - p0 : p0, t1 = dir ? 127 - p1 : p1;
            const float bi = p.m_gate_b[icol], bf = p.m_gate_b[fcol];
            const float i0 = gates[(T0 + t0) * 64 + icol] + bi, i1 = gates[(T0 + t1) * 64 + icol] + bi;
            const float f0 = logsig(gates[(T0 + t0) * 64 + fcol] + bf), f1 = logsig(gates[(T0 + t1) * 64 + fcol] + bf);
            float s = f0 + f1;
#pragma unroll
            for (int o = 1; o < 64; o <<= 1) { const float t = __shfl_up(s, o); if (lane >= o) s += t; }
            const float ex = s - (f0 + f1), bc0 = ex + f0, bc1 = ex + f0 + f1;
            const float btot = __shfl(s, 63);
            const float a0 = i0 - bc0, a1 = i1 - bc1;
            float pm = fmaxf(a0, a1);
#pragma unroll
            for (int o = 1; o < 64; o <<= 1) { const float t = __shfl_up(pm, o); if (lane >= o) pm = fmaxf(pm, t); }
            float pex = __shfl_up(pm, 1); if (lane == 0) pex = -3.0e38f;
            const float ml = wave_max(fmaxf(btot + a0, btot + a1));
            f32x4* mg = (f32x4*)mgate + ((size_t)(dir * 4 + h) * NT + T0);
            mg[t0] = (f32x4){bc0, i0, fmaxf(pex, a0), 0.f}; mg[t1] = (f32x4){bc1, i1, fmaxf(pex, fmaxf(a0, a1)), 0.f};
            if (lane == 0) { float* mc = mchunk + ((size_t)(dir * 4 + h) * 264 + ck) * 2; mc[0] = btot; mc[1] = ml; }
        };
        for (int i = tid; i < 9 * 1024 / 4; i += 512) ((f32x4*)(lds + 81920))[i] = ((const f32x4*)p.conv_w)[i];
        __syncthreads();
        for (int u = bid; u < 1024; u += G) { if (u < 512) conv_item(true, u >> 7, u & 127, 0); else gprep_item(u - 512); }
        for (int v = bid; v < 296; v += G) { if (v < 16) gprep_item(512 + v); else if (v < 32) conv_item(false, (v - 16) >> 2, 0, (v - 16) & 3); else mprep_item(v - 32); }
    }
    }
    xcd_barrier(bar);
    { int tid = threadIdx.x; asm volatile("" : "+v"(tid)); const int lane = tid & 63, wave = __builtin_amdgcn_readfirstlane(tid >> 6), gw = bid * 8 + wave; (void)lane; (void)gw;
    {
        uint4 kraw0, kraw1, kraw2, kraw3, vraw0, vraw1, vraw2, vraw3; float2 mgf0, mgf1, mgf2, mgf3, mgb0, mgb1, mgb2, mgb3; float btf = 0.f, mlf = 0.f, btb = 0.f, mlb = 0.f;
        kraw0 = kraw1 = kraw2 = kraw3 = vraw0 = vraw1 = vraw2 = vraw3 = make_uint4(0u, 0u, 0u, 0u); mgf0 = mgf1 = mgf2 = mgf3 = mgb0 = mgb1 = mgb2 = mgb3 = make_float2(0.f, 0.f);
#define P4A_FETCH(i) { const int id = tid + 512 * (i), r = id >> 4, c8 = (id & 15) * 8; \
            kraw##i = *(const uint4*)(qk + (T0 + r) * 1024 + 512 + h * 128 + c8); vraw##i = *(const uint4*)(zr + (T0 + r) * 2560 + h * 128 + c8); \
            mgf##i = *(const float2*)(mgate + ((size_t)(0 * 4 + h) * NT + T0 + r) * 4); mgb##i = *(const float2*)(mgate + ((size_t)(1 * 4 + h) * NT + T0 + r) * 4); }
#define P4A_STORE(i) { const int id = tid + 512 * (i), r = id >> 4, c8 = (id & 15) * 8; float v[8], o[8]; unpack8(kraw##i, v); \
            const float wf = __expf(btf - mgf##i.x + mgf##i.y - mlf), wb = __expf(btb - mgb##i.x + mgb##i.y - mlb); \
            _Pragma("unroll") for (int e = 0; e < 8; ++e) o[e] = v[e] * wf; \
            *(uint4*)(R1 + r * PITCH + c8) = pack8(o); \
            _Pragma("unroll") for (int e = 0; e < 8; ++e) o[e] = v[e] * wb; \
            *(uint4*)(R3 + r * PITCH + c8) = pack8(o); *(uint4*)(R2 + r * PITCH + c8) = vraw##i; }
        for (int it = bid - G;;) {
            Own own = make_own(threadIdx.x); asm volatile("" : "+v"(own.rbase), "+v"(own.cbase)); int tid = threadIdx.x; asm volatile("" : "+v"(tid));
            const int nx = it + G;
            if (nx < 1056) {
                const int bh = nx / 66, ci = nx % 66, b = bh >> 2, h = bh & 3;
                const int ck = ci < 2 ? 256 + b * 2 + ci : b * 64 + ci - 2;
                const size_t T0 = ck < 256 ? (size_t)ck * 128 : (size_t)NX + (size_t)(ck - 256) * 128;
                P4A_FETCH(0) P4A_FETCH(1) P4A_FETCH(2) P4A_FETCH(3)
                const float* mc0 = mchunk + ((size_t)(0 * 4 + h) * 264 + ck) * 2; const float* mc1 = mchunk + ((size_t)(1 * 4 + h) * 264 + ck) * 2;
                btf = mc0[0]; mlf = mc0[1]; btb = mc1[0]; mlb = mc1[1];
            }
            if (it >= 0) {
                const int bh = it / 66, ci = it % 66;
                const int slf = ci, slb = ci < 2 ? 1 - ci : 67 - ci;
                const int scf = bh, scb = 16 + bh;
                float accf[32], accb[32];
                zero32(accf); mm128<true, true>(accf, R1, R2, tid);
                zero32(accb); mm128<true, true>(accb, R3, R2, tid);
                if (tid < 256) { const int d = tid >> 7, dk = tid & 127; const bf16_t* src = d ? R3 : R1; float sum = 0.f;
                    for (int q = 0; q < 128; ++q) sum += bf2f(src[q * PITCH + dk]);
                    nst[((size_t)(d ? scb : scf) * 66 + (d ? slb : slf)) * 128 + dk] = sum; }
                __syncthreads();
#pragma unroll
                for (int idx = 0; idx < 32; ++idx) { R1[own.row(idx) * PITCH + own.col(idx)] = f2bf(accf[idx]); R3[own.row(idx) * PITCH + own.col(idx)] = f2bf(accb[idx]); }
                __syncthreads();
                { bf16_t* dstf = Cst + ((size_t)scf * 66 + slf) * 16384; bf16_t* dstb = Cst + ((size_t)scb * 66 + slb) * 16384;
#pragma unroll
                    for (int i = 0; i < 4; ++i) { const int id = tid + 512 * i, r = id >> 4, c8 = (id & 15) * 8;
                        *(uint4*)(dstf + r * 128 + c8) = *(const uint4*)(R1 + r * PITCH + c8); *(uint4*)(dstb + r * 128 + c8) = *(const uint4*)(R3 + r * PITCH + c8); } }
            }
            if (nx >= 1056) break;
            __syncthreads();
            P4A_STORE(0) P4A_STORE(1) P4A_STORE(2) P4A_STORE(3)
            __syncthreads();
            it = nx;
        }
    }
    __syncthreads();
    {
        uint4 kf0, kf1, kf2, kf3, kb0, kb1, kb2, kb3, vr0, vr1, vr2, vr3;
        kf0 = kf1 = kf2 = kf3 = kb0 = kb1 = kb2 = kb3 = vr0 = vr1 = vr2 = vr3 = make_uint4(0u, 0u, 0u, 0u);
#define P4G_FETCH(i) { const int id = tid + 512 * (i), r = id >> 4, c8 = (id & 15) * 8, jj = r >> 6; \
            uint4 a = make_uint4(0u, 0u, 0u, 0u), c = make_uint4(0u, 0u, 0u, 0u); \
            if ((c8 >> 6) == jj) { a = *(const uint4*)(ktf + (T0 + r) * 256 + h * 64 + (c8 & 63)); c = *(const uint4*)(ktb + (T0 + r) * 256 + h * 64 + (c8 & 63)); } \
            kf##i = a; kb##i = c; vr##i = *(const uint4*)(zr + (T0 + r) * 2560 + 1536 + h * 128 + c8); }
#define P4G_STORE(i) { const int id = tid + 512 * (i), r = id >> 4, c8 = (id & 15) * 8; \
            *(uint4*)(R1 + r * PITCH + c8) = kf##i; *(uint4*)(R3 + r * PITCH + c8) = kb##i; *(uint4*)(R2 + r * PITCH + c8) = vr##i; }
        for (int it = (G - 1 - bid) - G;;) {
            Own own = make_own(threadIdx.x); asm volatile("" : "+v"(own.rbase), "+v"(own.cbase)); int tid = threadIdx.x; asm volatile("" : "+v"(tid));
            const int nx = it + G;
            if (nx < 1056) {
                const int bh = nx / 66, pi = nx % 66, b = bh >> 2, h = bh & 3;
                const int gc0 = pi < 2 ? 512 + b * 4 + 2 * pi : b * 128 + 2 * (pi - 2);
                const size_t T0 = (size_t)gc0 * 64;
                const bf16_t* ktf = gqk + (size_t)1 * NT * 256; const bf16_t* ktb = gqk + (size_t)3 * NT * 256;
                P4G_FETCH(0) P4G_FETCH(1) P4G_FETCH(2) P4G_FETCH(3)
            }
            if (it >= 0) {
                const int bh = it / 66, pi = it % 66, b = bh >> 2, h = bh & 3;
                const bool isctx = pi < 2; const int c0 = isctx ? 2 * pi : 2 * (pi - 2);
                const int gc0 = isctx ? 512 + b * 4 + c0 : b * 128 + c0;
                const int scf = bh, scb = 16 + bh;
                float accf[32], accb[32];
                const int ksg = 4 * (((tid >> 6) & 3) >> 1);
                zero32(accf); mm128<true, true, 4>(accf, R1, R2, tid, ksg);
                zero32(accb); mm128<true, true, 4>(accb, R3, R2, tid, ksg);
                __syncthreads();
#pragma unroll
                for (int rs = 0; rs < 16; ++rs) { const int m = own.slotrow(rs), jj = m >> 6, dk = m & 63;
                    const float ef = __expf(gbt[((size_t)0 * 528 + gc0 + jj) * 256 + h * 64 + dk]), eb = __expf(gbt[((size_t)1 * 528 + gc0 + jj) * 256 + h * 64 + dk]);
                    R1[m * PITCH + own.col(rs)] = f2bf(accf[rs] * ef); R1[m * PITCH + own.col(16 + rs)] = f2bf(accf[16 + rs] * ef);
                    R3[m * PITCH + own.col(rs)] = f2bf(accb[rs] * eb); R3[m * PITCH + own.col(16 + rs)] = f2bf(accb[16 + rs] * eb); }
                __syncthreads();
#pragma unroll
                for (int i = 0; i < 4; ++i) { const int id = tid + 512 * i, r = id >> 4, c8 = (id & 15) * 8, jj = r >> 6, dk = r & 63, cc = c0 + jj;
                    const int slf = isctx ? cc : 4 + cc, slb = isctx ? 3 - cc : 131 - cc;
                    *(uint4*)(Sst + ((size_t)scf * 132 + slf) * 8192 + dk * 128 + c8) = *(const uint4*)(R1 + r * PITCH + c8);
                    *(uint4*)(Sst + ((size_t)scb * 132 + slb) * 8192 + dk * 128 + c8) = *(const uint4*)(R3 + r * PITCH + c8); }
            }
            if (nx >= 1056) break;
            __syncthreads();
            P4G_STORE(0) P4G_STORE(1) P4G_STORE(2) P4G_STORE(3)
            __syncthreads();
            it = nx;
        }
    }
    }
    xcd_barrier(bar);
    { int tid = threadIdx.x; asm volatile("" : "+v"(tid)); const int lane = tid & 63, wave = __builtin_amdgcn_readfirstlane(tid >> 6), gw = bid * 8 + wave; (void)lane; (void)gw;
    for (int e = bid * 512 + tid; e < 131072; e += G * 512) {
        if (e < 65536) {
            const int sc = e >> 11, off = (e & 2047) * 8, dir = sc >> 4, b = (sc >> 2) & 3, h = sc & 3;
            bf16_t* base = Cst + (size_t)sc * 66 * 16384 + off; const float* mcb = mchunk + (size_t)(dir * 4 + h) * 264 * 2;
            float C[8] = {0.f, 0.f, 0.f, 0.f, 0.f, 0.f, 0.f, 0.f}; float m = -1e30f;
            uint4 ld[11];
#pragma unroll
            for (int u = 0; u < 11; ++u) ld[u] = *(const uint4*)(base + (size_t)u * 16384);
            for (int s0 = 0; s0 < 66; s0 += 11) {
#pragma unroll
                for (int u = 0; u < 11; ++u) { const int slot = s0 + u;
                    const uint4 cur = ld[u];
                    if (slot + 11 < 66) ld[u] = *(const uint4*)(base + (size_t)(slot + 11) * 16384);
                    const int ck = slot < 2 ? 256 + b * 2 + (dir ? 1 - slot : slot) : b * 64 + (dir ? 65 - slot : slot - 2);
                    const float btot = mcb[ck * 2], mloc = mcb[ck * 2 + 1];
                    *(uint4*)(base + (size_t)slot * 16384) = pack8(C);
                    const float mn = fmaxf(m + btot, mloc), a = __expf(m + btot - mn), bb = __expf(mloc - mn);
                    float v[8]; unpack8(cur, v);
#pragma unroll
                    for (int q = 0; q < 8; ++q) C[q] = a * C[q] + bb * v[q];
                    m = mn; }
            }
            if (e < 4096) {
                const int sc2 = e >> 7, dk = e & 127, dir2 = sc2 >> 4, b2 = (sc2 >> 2) & 3, h2 = sc2 & 3;
                float* nb = nst + (size_t)sc2 * 66 * 128 + dk; const float* mcb2 = mchunk + (size_t)(dir2 * 4 + h2) * 264 * 2;
                float n = 0.f, m2 = -1e30f;
                float lq[6]; float2 mq2[6];
#pragma unroll
                for (int u = 0; u < 6; ++u) { lq[u] = nb[u * 128];
                    const int ck0 = u < 2 ? 256 + b2 * 2 + (dir2 ? 1 - u : u) : b2 * 64 + (dir2 ? 65 - u : u - 2); mq2[u] = *(const float2*)(mcb2 + ck0 * 2); }
                for (int s0 = 0; s0 < 66; s0 += 6) {
#pragma unroll
                    for (int u = 0; u < 6; ++u) { const int slot = s0 + u;
                        const float loc = lq[u], btot = mq2[u].x, mloc = mq2[u].y;
                        if (slot + 6 < 66) { const int sn = slot + 6; lq[u] = nb[sn * 128]; const int ckn = b2 * 64 + (dir2 ? 65 - sn : sn - 2); mq2[u] = *(const float2*)(mcb2 + ckn * 2); }
                        nb[slot * 128] = n; if (dk == 0) mstate[sc2 * 66 + slot] = m2;
                        const float mn = fmaxf(m2 + btot, mloc), a = __expf(m2 + btot - mn), bb = __expf(mloc - mn);
                        n = a * n + bb * loc; m2 = mn; }
                }
            }
        } else {
            const int e1 = e - 65536, sc = e1 >> 11, off = (e1 & 2047) * 4, dk = off >> 7, dir = sc >> 4, b = (sc >> 2) & 3, h = sc & 3;
            bf16_t* base = Sst + (size_t)sc * 132 * 8192 + off;
            float S[4] = {0.f, 0.f, 0.f, 0.f};
            uint2 ld[12];
#pragma unroll
            for (int u = 0; u < 12; ++u) ld[u] = *(const uint2*)(base + (size_t)u * 8192);
            for (int s0 = 0; s0 < 132; s0 += 12) {
#pragma unroll
                for (int u = 0; u < 12; ++u) { const int sl = s0 + u;
                    const uint2 cur = ld[u];
                    if (sl + 12 < 132) ld[u] = *(const uint2*)(base + (size_t)(sl + 12) * 8192);
                    const int gc = sl < 4 ? 512 + b * 4 + (dir ? 3 - sl : sl) : b * 128 + (dir ? 131 - sl : sl - 4);
                    const float dec = __expf(gbt[((size_t)dir * 528 + gc) * 256 + h * 64 + dk]);
                    uint2 o; o.x = pk2(S[0], S[1]); o.y = pk2(S[2], S[3]);
                    *(uint2*)(base + (size_t)sl * 8192) = o;
                    S[0] = dec * S[0] + __uint_as_float(cur.x << 16); S[1] = dec * S[1] + __uint_as_float(cur.x & 0xffff0000u);
                    S[2] = dec * S[2] + __uint_as_float(cur.y << 16); S[3] = dec * S[3] + __uint_as_float(cur.y & 0xffff0000u); }
            }
        }
    }
    }
    xcd_barrier(bar);
    { int tid = threadIdx.x; asm volatile("" : "+v"(tid)); const int lane = tid & 63, wave = __builtin_amdgcn_readfirstlane(tid >> 6), gw = bid * 8 + wave; (void)lane; (void)gw;
    for (int it = bid; it < 1024; it += G) {
        int tid = threadIdx.x; asm volatile("" : "+v"(tid));
        const int lane = tid & 63, w = tid >> 6, fr = lane & 15, fq = lane >> 4;
        const int b = it >> 8, h = (it >> 6) & 3, c = it & 63; const size_t T0 = (size_t)b * 8192 + c * 128;
        float* bc = smf; float* ig = smf + 256; float* mt = smf + 512; float* wint = smf + 768; float* qn = smf + 1280; float* nprev = smf + 1792;
        const int scf = (b * 4 + h), scb = 16 + (b * 4 + h), slf = 2 + c, slb = 65 - c;
        __syncthreads();
        load_img(R1, qk + T0 * 1024 + 512 + h * 128, 1024, tid);
        load_img_sw(R2, zr + T0 * 2560 + h * 128, 2560, tid);
        load_img_sw(R3, Cst + ((size_t)scf * 66 + slf) * 16384, 128, tid);
        load_img_sw(R4, Cst + ((size_t)scb * 66 + slb) * 16384, 128, tid);
        bf16x8 qa[4];
#pragma unroll
        for (int ks = 0; ks < 4; ++ks) qa[ks] = *(const bf16x8*)(qk + (T0 + 16 * w + fr) * 1024 + h * 128 + 32 * ks + 8 * fq);
        { const int dir = (tid >> 7) & 1, t = tid & 127, scd = dir ? scb : scf, sld = dir ? slb : slf;
            if (tid < 256) { const f32x4 mg = ((const f32x4*)mgate)[(size_t)(dir * 4 + h) * NT + T0 + t]; const float mprev = mstate[scd * 66 + sld];
                bc[tid] = mg.x; ig[tid] = mg.y; const float mtv = mg.x + fmaxf(mprev, mg.z); mt[tid] = mtv; wint[tid] = __expf(mprev + mg.x - mtv);
                nprev[tid] = nst[((size_t)scd * 66 + sld) * 128 + t]; } }
        uint4 mo0, mo1, mo2, mo3;
        { const bf16_t* mg_ = zr + (T0 + 16 * w) * 2560 + 512 + h * 128;
            mo0 = *(const uint4*)(mg_ + (size_t)(lane >> 3) * 2560 + (lane & 7) * 8); mo1 = *(const uint4*)(mg_ + (size_t)((lane >> 3) + 8) * 2560 + (lane & 7) * 8);
            mo2 = *(const uint4*)(mg_ + (size_t)(lane >> 3) * 2560 + 64 + (lane & 7) * 8); mo3 = *(const uint4*)(mg_ + (size_t)((lane >> 3) + 8) * 2560 + 64 + (lane & 7) * 8); }
        __syncthreads();
        {
            float q0 = 0.f, q1 = 0.f;
#pragma unroll
            for (int ks = 0; ks < 4; ++ks) { float v[8]; unpack8(__builtin_bit_cast(uint4, qa[ks]), v);
                const f32x4 n0 = *(const f32x4*)(nprev + 32 * ks + 8 * fq), n1 = *(const f32x4*)(nprev + 32 * ks + 8 * fq + 4), m0 = *(const f32x4*)(nprev + 128 + 32 * ks + 8 * fq), m1 = *(const f32x4*)(nprev + 128 + 32 * ks + 8 * fq + 4);
                q0 += (v[0] * n0.x + v[1] * n0.y) + (v[2] * n0.z + v[3] * n0.w) + (v[4] * n1.x + v[5] * n1.y) + (v[6] * n1.z + v[7] * n1.w);
                q1 += (v[0] * m0.x + v[1] * m0.y) + (v[2] * m0.z + v[3] * m0.w) + (v[4] * m1.x + v[5] * m1.y) + (v[6] * m1.z + v[7] * m1.w); }
            q0 += __shfl_xor(q0, 16); q0 += __shfl_xor(q0, 32); q1 += __shfl_xor(q1, 16); q1 += __shfl_xor(q1, 32);
            if (fq == 0) { qn[16 * w + fr] = q0; qn[128 + 16 * w + fr] = q1; }
        }
        f32x4 S[8];
#pragma unroll
        for (int ct = 0; ct < 8; ++ct) { S[ct] = (f32x4){0.f, 0.f, 0.f, 0.f};
#pragma unroll
            for (int ks = 0; ks < 4; ++ks) { const bf16x8 kb = *(const LAS3 bf16x8*)(R1 + (16 * ct + fr) * PITCH + 32 * ks + 8 * fq); S[ct] = __builtin_amdgcn_mfma_f32_16x16x32_bf16(qa[ks], kb, S[ct], 0, 0, 0); } }
        __syncthreads();
        bf16_t* Pw = R1 + 16 * w * PITCH;
        f32x4 tot[8];
#pragma unroll
        for (int ct = 0; ct < 8; ++ct) tot[ct] = (f32x4){0.f, 0.f, 0.f, 0.f};
        const int trq = (fr >> 2) * PITCH + 32 * ((fr & 3) >> 1) + 4 * (fr & 1);
#define TRC(ct) (8 * ((((ct) >> 1) & 1) + 2 * ((ct) & 1) + 8 * ((ct) >> 2)))
#pragma unroll
        for (int d = 0; d < 2; ++d) {
            const float* bcd = bc + 128 * d; const float* igd = ig + 128 * d; const float* mtd = mt + 128 * d; const float* wid = wint + 128 * d; const float* qnd = qn + 128 * d;
            float rt[4], rsm[4];
#pragma unroll
            for (int r = 0; r < 4; ++r) { const int t = 16 * w + 4 * fq + r; rt[r] = bcd[t] - mtd[t]; rsm[r] = 0.f; }
#pragma unroll
            for (int ct = 0; ct < 8; ++ct) { const int s = 16 * ct + fr; const float ctm = igd[s] - bcd[s];
#pragma unroll
                for (int r = 0; r < 4; ++r) { const int t = 16 * w + 4 * fq + r; const bool on = d ? (s >= t) : (s <= t);
                    const float pv = on ? S[ct][r] * __expf(rt[r] + ctm) : 0.f; rsm[r] += pv; Pw[(4 * fq + r) * PITCH + s] = f2bf(pv); } }
            float rd[4];
#pragma unroll
            for (int r = 0; r < 4; ++r) { float x = rsm[r]; x += __shfl_xor(x, 1); x += __shfl_xor(x, 2); x += __shfl_xor(x, 4); x += __shfl_xor(x, 8);
                const int t = 16 * w + 4 * fq + r; const float den = wid[t] * qnd[t] + x; rd[r] = 1.0f / fmaxf(fabsf(den), __expf(-mtd[t])); }
            asm volatile("s_waitcnt lgkmcnt(0)" ::: "memory"); __builtin_amdgcn_wave_barrier();
            f32x4 num[8], tmp[8];
#pragma unroll
            for (int ct = 0; ct < 8; ++ct) { num[ct] = (f32x4){0.f, 0.f, 0.f, 0.f}; tmp[ct] = (f32x4){0.f, 0.f, 0.f, 0.f}; }
            const int ksl = d ? (w >> 1) : 0, ksh = d ? 3 : (w >> 1);
            for (int ks = ksl; ks <= ksh; ++ks) {
                const bf16x8 pa = *(const LAS3 bf16x8*)(Pw + fr * PITCH + 32 * ks + 8 * fq);
                const bf16_t* vb = R2 + (32 * ks + 8 * fq) * PITCH + trq;
#pragma unroll
                for (int ct = 0; ct < 8; ++ct) { const s16x4 lo = trrd(vb + TRC(ct)), hi = trrd(vb + 4 * PITCH + TRC(ct));
                    num[ct] = __builtin_amdgcn_mfma_f32_16x16x32_bf16(pa, __builtin_shufflevector(lo, hi, 0, 1, 2, 3, 4, 5, 6, 7), num[ct], 0, 0, 0); }
            }
            const bf16_t* Cd = d ? R4 : R3;
#pragma unroll
            for (int ks = 0; ks < 4; ++ks) {
                const bf16_t* cb = Cd + (32 * ks + 8 * fq) * PITCH + trq;
#pragma unroll
                for (int ct = 0; ct < 8; ++ct) { const s16x4 lo = trrd(cb + TRC(ct)), hi = trrd(cb + 4 * PITCH + TRC(ct));
                    tmp[ct] = __builtin_amdgcn_mfma_f32_16x16x32_bf16(qa[ks], __builtin_shufflevector(lo, hi, 0, 1, 2, 3, 4, 5, 6, 7), tmp[ct], 0, 0, 0); }
            }
#pragma unroll
            for (int r = 0; r < 4; ++r) { const float wv = wid[16 * w + 4 * fq + r];
#pragma unroll
                for (int ct = 0; ct < 8; ++ct) tot[ct][r] += (num[ct][r] + tmp[ct][r] * wv) * rd[r]; }
            asm volatile("" ::: "memory"); __builtin_amdgcn_wave_barrier();
        }
        float rsn[4];
#pragma unroll
        for (int r = 0; r < 4; ++r) { float x = 0.f;
#pragma unroll
            for (int ct = 0; ct < 8; ++ct) x += tot[ct][r] * tot[ct][r];
            x += __shfl_xor(x, 1); x += __shfl_xor(x, 2); x += __shfl_xor(x, 4); x += __shfl_xor(x, 8);
            rsn[r] = rsqrtf(x * (1.0f / 128.0f) + EPSN); }
        float* Hw = (float*)Pw;
#pragma unroll
        for (int hf = 0; hf < 2; ++hf) {
#pragma unroll
            for (int c4 = 0; c4 < 4; ++c4)
#pragma unroll
                for (int r = 0; r < 4; ++r) Hw[(4 * fq + r) * 68 + 16 * c4 + fr] = tot[4 * hf + c4][r] * rsn[r];
            asm volatile("s_waitcnt lgkmcnt(0)" ::: "memory"); __builtin_amdgcn_wave_barrier();
#pragma unroll
            for (int i = 0; i < 2; ++i) { const int pz = lane + 64 * i, row = pz >> 3, c8 = (pz & 7) * 8, dv0 = 64 * hf + c8;
                float mo[8]; unpack8(hf == 0 ? (i == 0 ? mo0 : mo1) : (i == 0 ? mo2 : mo3), mo); float o[8];
                const f32x4 g0 = *(const f32x4*)(p.m_norm_g + h * 128 + dv0), g1 = *(const f32x4*)(p.m_norm_g + h * 128 + dv0 + 4);
                const f32x4 h0 = *(const f32x4*)(Hw + row * 68 + c8), h1 = *(const f32x4*)(Hw + row * 68 + c8 + 4);
                o[0] = h0.x * g0.x * sigm(mo[0]); o[1] = h0.y * g0.y * sigm(mo[1]); o[2] = h0.z * g0.z * sigm(mo[2]); o[3] = h0.w * g0.w * sigm(mo[3]);
                o[4] = h1.x * g1.x * sigm(mo[4]); o[5] = h1.y * g1.y * sigm(mo[5]); o[6] = h1.z * g1.z * sigm(mo[6]); o[7] = h1.w * g1.w * sigm(mo[7]);
                *(uint4*)(mix + (T0 + 16 * w + row) * 1024 + h * 128 + dv0) = pack8(o); }
            asm volatile("s_waitcnt lgkmcnt(0)" ::: "memory"); __builtin_amdgcn_wave_barrier();
        }
    }
    for (int it = 1024 + bid; it < 2048; it += G) {
        Own own = make_own(threadIdx.x); asm volatile("" : "+v"(own.rbase), "+v"(own.cbase)); int tid = threadIdx.x; asm volatile("" : "+v"(tid));
        {
            const int i2 = it - 1024, b = i2 >> 8, h = (i2 >> 6) & 3, pp = i2 & 63; const size_t T0 = (size_t)b * 8192 + pp * 128;
            const int scf = b * 4 + h, scb = 16 + b * 4 + h, c0 = 2 * pp, c1 = 2 * pp + 1;
            const bf16_t* qf = gqk + (size_t)0 * NT * 256; const bf16_t* kf = gqk + (size_t)1 * NT * 256; const bf16_t* qb = gqk + (size_t)2 * NT * 256; const bf16_t* kb = gqk + (size_t)3 * NT * 256;
            __syncthreads();
#pragma unroll
            for (int i = 0; i < 4; ++i) { const int id = tid + 512 * i, r = id >> 4, c8 = (id & 15) * 8, jj = r >> 6; const bool on = (c8 >> 6) == jj; const size_t go = (T0 + r) * 256 + h * 64 + (c8 & 63);
                uint4 va = make_uint4(0u, 0u, 0u, 0u), vb = va, vc = va, vd = va;
                if (on) { va = *(const uint4*)(qf + go); vb = *(const uint4*)(kf + go); vc = *(const uint4*)(qb + go); vd = *(const uint4*)(kb + go); }
                *(uint4*)(R1 + r * PITCH + c8) = va; *(uint4*)(R2 + r * PITCH + c8) = vb; *(uint4*)(R3 + r * PITCH + c8) = vc; *(uint4*)(R4 + r * PITCH + c8) = vd; }
            uint4 pa0, pa1, pa2, pa3, pb0, pb1, pb2, pb3;
#define P5G_FETCH(x0, x1, x2, x3, src, gp) { const bf16_t* g_ = (src) + (size_t)(tid >> 4) * (gp) + (tid & 15) * 8; x0 = *(const uint4*)(g_); x1 = *(const uint4*)(g_ + (size_t)32 * (gp)); x2 = *(const uint4*)(g_ + (size_t)64 * (gp)); x3 = *(const uint4*)(g_ + (size_t)96 * (gp)); }
#define P5G_STORE(img, x0, x1, x2, x3) { bf16_t* i_ = (img) + (tid >> 4) * PITCH + (tid & 15) * 8; *(uint4*)(i_) = x0; *(uint4*)(i_ + 32 * PITCH) = x1; *(uint4*)(i_ + 64 * PITCH) = x2; *(uint4*)(i_ + 96 * PITCH) = x3; }
            P5G_FETCH(pa0, pa1, pa2, pa3, zr + T0 * 2560 + 1536 + h * 128, 2560)
            __syncthreads();
            float Sf[32], Sb[32]; zero32(Sf); zero32(Sb);
            const int ksg = 4 * (((tid >> 6) & 3) >> 1);
            mm128<false, false, 4>(Sf, R1, R2, tid, ksg);
            mm128<false, false, 4>(Sb, R3, R4, tid, ksg);
            __syncthreads();
#pragma unroll
            for (int idx = 0; idx < 32; ++idx) { const int tt = own.row(idx), s = own.col(idx); R2[tt * PITCH + s] = f2bf((s <= tt ? Sf[idx] : 0.f) + (s >= tt ? Sb[idx] : 0.f)); }
            P5G_STORE(R4, pa0, pa1, pa2, pa3)
            {
                const int dk0 = tid >> 4, c8 = (tid & 15) * 8;
                const bf16_t* sf0 = Sst + ((size_t)scf * 132 + 4 + c0) * 8192; const bf16_t* sf1 = Sst + ((size_t)scf * 132 + 4 + c1) * 8192;
                const bf16_t* sb0 = Sst + ((size_t)scb * 132 + 131 - c0) * 8192; const bf16_t* sb1 = Sst + ((size_t)scb * 132 + 131 - c1) * 8192;
                pa0 = *(const uint4*)(sf0 + dk0 * 128 + c8); pa1 = *(const uint4*)(sf0 + (dk0 + 32) * 128 + c8); pa2 = *(const uint4*)(sf1 + dk0 * 128 + c8); pa3 = *(const uint4*)(sf1 + (dk0 + 32) * 128 + c8);
                pb0 = *(const uint4*)(sb0 + dk0 * 128 + c8); pb1 = *(const uint4*)(sb0 + (dk0 + 32) * 128 + c8); pb2 = *(const uint4*)(sb1 + dk0 * 128 + c8); pb3 = *(const uint4*)(sb1 + (dk0 + 32) * 128 + c8); }
            __syncthreads();
            float tot[32]; zero32(tot);
            mm128<false, true, 4>(tot, R2, R4, tid, ksg);
            __syncthreads();
            P5G_STORE(R2, pa0, pa1, pa2, pa3) P5G_STORE(R4, pb0, pb1, pb2, pb3)
            { const bf16_t* g_ = zr + (T0 + (tid >> 2)) * 2560 + 2048 + h * 128 + (tid & 3) * 32; pa0 = *(const uint4*)(g_); pa1 = *(const uint4*)(g_ + 8); pa2 = *(const uint4*)(g_ + 16); pa3 = *(const uint4*)(g_ + 24); }
            __syncthreads();
            mm128<false, true, 4>(tot, R1, R2, tid, ksg);
            mm128<false, true, 4>(tot, R3, R4, tid, ksg);
            __syncthreads();
#pragma unroll
            for (int idx = 0; idx < 32; ++idx) Himg[own.row(idx) * 132 + own.col(idx)] = tot[idx];
            __syncthreads();
            { const int tr = tid >> 2, part = tid & 3; float ss = 0.f;
#pragma unroll
                for (int j = 0; j < 8; ++j) { const f32x4 v = *(const f32x4*)(Himg + tr * 132 + part * 32 + 4 * j); ss += (v.x * v.x + v.y * v.y) + (v.z * v.z + v.w * v.w); }
                ss += __shfl_xor(ss, 1); ss += __shfl_xor(ss, 2);
                const float rs = rsqrtf(ss * (1.0f / 128.0f) + EPSN);
#pragma unroll
                for (int j8 = 0; j8 < 4; ++j8) { const int col = part * 32 + j8 * 8;
                    float gr[8]; unpack8(j8 == 0 ? pa0 : (j8 == 1 ? pa1 : (j8 == 2 ? pa2 : pa3)), gr); float o[8];
                    const f32x4 g0 = *(const f32x4*)(p.g_norm_g + h * 128 + col), g1 = *(const f32x4*)(p.g_norm_g + h * 128 + col + 4);
                    const f32x4 h0 = *(const f32x4*)(Himg + tr * 132 + col), h1 = *(const f32x4*)(Himg + tr * 132 + col + 4);
                    o[0] = h0.x * rs * g0.x * (gr[0] * sigm(gr[0])); o[1] = h0.y * rs * g0.y * (gr[1] * sigm(gr[1])); o[2] = h0.z * rs * g0.z * (gr[2] * sigm(gr[2])); o[3] = h0.w * rs * g0.w * (gr[3] * sigm(gr[3]));
                    o[4] = h1.x * rs * g1.x * (gr[4] * sigm(gr[4])); o[5] = h1.y * rs * g1.y * (gr[5] * sigm(gr[5])); o[6] = h1.z * rs * g1.z * (gr[6] * sigm(gr[6])); o[7] = h1.w * rs * g1.w * (gr[7] * sigm(gr[7]));
                    *(uint4*)(mix + (T0 + tr) * 1024 + 512 + h * 128 + col) = pack8(o); } }
        }
    }
    __syncthreads();
    }
    xcd_barrier(bar);
    {
        pg8::Gemm g{mix, Wt_out, NX, 1024, 1024}; pg8::StaticOrder S; S.init(NX, 1024, G, bid);
        pg8::EpiResB<false> E{p.x, xres, mod, 2048};
        pg8::gemm_phase<pg8::EpiResB<false>, pg8::StaticOrder, true, true>((PG8_LAS unsigned char*)lds, g, S, E);
    }
    xcd_barrier(bar);
    { int tid = threadIdx.x; asm volatile("" : "+v"(tid)); const int lane = tid & 63, wave = __builtin_amdgcn_readfirstlane(tid >> 6), gw = bid * 8 + wave; (void)lane; (void)gw;
    norm_rows_b(xres, hbuf, nullptr, NX, p.g_ffn, mod, 3072, 4096, gw, ngw, lane);
    }
    xcd_barrier(bar);
    {
        pg8::Gemm g{hbuf, Wt_gu, NX, 5632, 1024}; pg8::StaticOrder S; S.init(NX, 5632, G, bid);
        pg8::EpiGU E{act};
        pg8::gemm_phase<pg8::EpiGU, pg8::StaticOrder, true, true>((PG8_LAS unsigned char*)lds, g, S, E);
    }
    xcd_barrier(bar);
    {
        pg8::Gemm g{act, Wt_dn, NX, 1024, DFF}; pg8::StaticOrder S; S.init(NX, 1024, G, bid);
        pg8::EpiResB<true> E{xres, xres, mod, 5120};
        pg8::gemm_phase<pg8::EpiResB<true>, pg8::StaticOrder, true, true>((PG8_LAS unsigned char*)lds, g, S, E);
    }
    xcd_barrier(bar);
    { int tid = threadIdx.x; asm volatile("" : "+v"(tid)); const int lane = tid & 63, wave = __builtin_amdgcn_readfirstlane(tid >> 6), gw = bid * 8 + wave; (void)lane; (void)gw;
    norm_rows_b(xres, nullptr, p.out, NX, p.g_final, mod, 0, 0, gw, ngw, lane);
    }
}

extern "C" void kernel_launch(void* const* d_in, const int* in_sizes, int n_in, void* d_out, int out_size, void* d_ws, size_t ws_size, hipStream_t stream) {
    static int grid = 0;
    if (grid == 0) {
        if (n_in != 19 || out_size != NX * 1024 || ws_size < WS_END) { fprintf(stderr, "kernel_launch: unexpected shapes (n_in %d out %d ws %zu)\n", n_in, out_size, ws_size); grid = -1; return; }
        int dev = 0, cus = 0, per_cu = 0;
        hipGetDevice(&dev); hipDeviceGetAttribute(&cus, hipDeviceAttributeMultiprocessorCount, dev);
        if (hipFuncSetAttribute((const void*)mega_fwd, hipFuncAttributeMaxDynamicSharedMemorySize, LDS_BYTES) != hipSuccess) { fprintf(stderr, "kernel_launch: hipFuncSetAttribute failed\n"); grid = -1; return; }
        if (hipOccupancyMaxActiveBlocksPerMultiprocessor(&per_cu, (const void*)mega_fwd, 512, LDS_BYTES) != hipSuccess || per_cu < 1) { fprintf(stderr, "kernel_launch: occupancy query gave %d\n", per_cu); per_cu = 1; }
        (void)hipGetLastError();
        grid = cus * 1;
        if (grid <= 0) grid = 256;
    }
    if (grid < 0) return;
    if (hipMemsetAsync((unsigned char*)d_ws + WS_SMALL + SM_BAR, 0, 16384 + 256, stream) != hipSuccess) { fprintf(stderr, "kernel_launch: memset of the barrier words failed\n"); return; }
    Params p{};
    const float** pp = (const float**)&p;
    for (int i = 0; i < 19; ++i) pp[i] = (const float*)d_in[i];
    p.out = (float*)d_out; p.ws = (unsigned char*)d_ws;
    void* args[] = {&p};
    hipError_t e = hipLaunchCooperativeKernel((const void*)mega_fwd, dim3(grid), dim3(512), args, LDS_BYTES, stream);
    if (e != hipSuccess) fprintf(stderr, "cooperative launch failed: %s (grid %d)\n", hipGetErrorString(e), grid);
}
```
